# Optimizing an MI355X kernel written in HIP

```python
import math
import jax, jax.numpy as jnp
from jax import lax
import numpy as np

D_MODEL = 1024
BATCH = 16
SEQ = 256
DEPTH = 4
DEC_BATCH = 8
DEC_SEQ = 4096
PAST_LEN = 256

GRID_W = 64
FOU_GROUPS = 4
FOU_GROUP_W = 128
FOU_W = FOU_GROUPS * FOU_GROUP_W
GLA_HEADS = 4
GLA_DK = 64
GLA_DV = 128
GLA_K = GLA_HEADS * GLA_DK
GLA_V = GLA_HEADS * GLA_DV
GATE_RANK = 16
GATE_TEMP = 16.0
GLA_CHUNK = 64
DIFF_HEADS = 4
DIFF_HEAD_DIM = 64
DIFF_V_HEAD = 2 * DIFF_HEAD_DIM
DIFF_QK = DIFF_HEADS * 2 * DIFF_HEAD_DIM
DIFF_V = DIFF_HEADS * DIFF_V_HEAD
Q_BLOCK = 128
ROPE_AXIS_DIM = DIFF_HEAD_DIM // 2
ROPE_FREQS = ROPE_AXIS_DIM // 2
ROPE_BASE = 10000.0
N_BRANCH = 3
D_FF = ((8 * D_MODEL // 3 + 255) // 256) * 256
PROJ_SIZES = (FOU_W, GLA_K, GLA_K, GLA_V, GLA_V, 2 * GATE_RANK, DIFF_QK, DIFF_QK, DIFF_V, N_BRANCH * D_MODEL)
IN_COLS = FOU_W + 2 * GLA_K + 2 * GLA_V + 2 * GATE_RANK + 2 * DIFF_QK + DIFF_V + N_BRANCH * D_MODEL

kernel_name = 'hybrid_fnet_gla_diffattn_prefix_dit_step'


def rms_norm(x, gain, eps=1e-6):
    xf = x.astype(jnp.float32)
    y = xf * lax.rsqrt(jnp.mean(xf * xf, axis=-1, keepdims=True) + eps)
    return (y * gain.astype(jnp.float32)).astype(x.dtype)


def split_projection(proj):
    outs, start = [], 0
    for size in PROJ_SIZES:
        outs.append(proj[..., start:start + size])
        start += size
    return outs


def fourier_mix(u):
    b, t, _ = u.shape
    ug = u.astype(jnp.float32).reshape(b, t, FOU_GROUPS, FOU_GROUP_W)
    f = jnp.fft.fft2(ug, axes=(1, 3), norm='ortho').real
    return f.reshape(b, t, FOU_W).astype(u.dtype)


def gla_log_gates(a_lr, w_a2, b_a):
    b, t = a_lr.shape[:2]
    z = jnp.einsum('btdr,drk->btdk', a_lr.reshape(b, t, 2, GATE_RANK), w_a2) + b_a
    return (jax.nn.log_sigmoid(z.astype(jnp.float32)) / GATE_TEMP).reshape(b, t, 2, GLA_HEADS, GLA_DK)


def gla_scan(q, k, v, log_a, s0):
    b, t, h, dk = q.shape
    dv = v.shape[-1]
    n = t // GLA_CHUNK
    def chunks(a):
        return jnp.moveaxis(a.astype(jnp.float32).reshape(b, n, GLA_CHUNK, *a.shape[2:]), 1, 0)
    causal = jnp.tril(jnp.ones((GLA_CHUNK, GLA_CHUNK), dtype=bool))
    def step(s, inp):
        qc, kc, vc, gc = inp
        cum = jnp.cumsum(gc, axis=1)
        o_inter = jnp.einsum('bihk,bhkv->bihv', qc * jnp.exp(cum), s)
        rel = cum[:, :, None] - cum[:, None, :]
        decay = jnp.exp(jnp.where(causal[None, :, :, None, None], rel, -jnp.inf))
        att = jnp.einsum('bihk,bjhk,bijhk->bhij', qc, kc, decay)
        o = o_inter + jnp.einsum('bhij,bjhv->bihv', att, vc)
        last = cum[:, -1]
        k_dec = kc * jnp.exp(last[:, None] - cum)
        s_new = jnp.exp(last)[..., None] * s + jnp.einsum('bjhk,bjhv->bhkv', k_dec, vc)
        return s_new, o
    s_fin, o = lax.scan(step, s0.astype(jnp.float32), (chunks(q), chunks(k), chunks(v), chunks(log_a)))
    o = jnp.moveaxis(o, 0, 1).reshape(b, t, h, dv)
    return o, s_fin


def gla_bidirectional(q, k, v, log_a, s0):
    o_f, s_f = gla_scan(q, k, v, log_a[:, :, 0], s0[:, 0])
    flip = lambda a: jnp.flip(a, axis=1)
    o_b, s_b = gla_scan(flip(q), flip(k), flip(v), flip(log_a[:, :, 1]), s0[:, 1])
    return o_f + flip(o_b), jnp.stack([s_f, s_b], axis=1)


def axial_rope(n_tokens):
    rows = n_tokens // GRID_W
    row = jnp.repeat(jnp.arange(rows), GRID_W).astype(jnp.float32)
    col = jnp.tile(jnp.arange(GRID_W), rows).astype(jnp.float32)
    inv = ROPE_BASE ** (-jnp.arange(ROPE_FREQS, dtype=jnp.float32) * 2.0 / ROPE_AXIS_DIM)
    ang_r = row[:, None] * inv
    ang_c = col[:, None] * inv
    ang = jnp.concatenate([ang_r, ang_r, ang_c, ang_c], axis=-1)
    return jnp.cos(ang), jnp.sin(ang)


def rotate_half_axial(x):
    xs = x.reshape(*x.shape[:-1], 2, 2, ROPE_FREQS)
    return jnp.stack([-xs[..., 1, :], xs[..., 0, :]], axis=-2).reshape(x.shape)


def apply_rope(x, cos, sin):
    xf = x.astype(jnp.float32)
    cs = cos[None, :, None, None, :]
    sn = sin[None, :, None, None, :]
    return (xf * cs + rotate_half_axial(xf) * sn).astype(x.dtype)


def diff_attend(q, k, v, lam):
    b, tq, h, _, d = q.shape
    dv = v.shape[-1]
    nb = tq // Q_BLOCK
    qb = jnp.moveaxis(q.reshape(b, nb, Q_BLOCK, h, 2, d), 1, 0)
    kf = k.astype(jnp.float32)
    vf = v.astype(jnp.float32)
    scale = d ** -0.5
    def block(qblk):
        s = jnp.einsum('bqhmd,bkhmd->bhmqk', qblk.astype(jnp.float32), kf) * scale
        p = jax.nn.softmax(s, axis=-1)
        w = p[:, :, 0] - lam * p[:, :, 1]
        return jnp.einsum('bhqk,bkhv->bqhv', w, vf)
    o = lax.map(block, qb)
    return jnp.moveaxis(o, 0, 1).reshape(b, tq, h, dv).astype(v.dtype)


def trunk_layer(x, cond, layer_idx, p, rope, ctx):
    b, t, _ = x.shape
    mod = jnp.einsum('bd,de->be', jax.nn.silu(cond), p['w_mod']) + p['b_mod']
    sh1, sc1, g1, sh2, sc2, g2 = jnp.split(mod[:, None, :], 6, axis=-1)
    h = rms_norm(x, p['norm1']) * (1 + sc1) + sh1
    u_f, q_g, k_g, v_g, r_g, a_g, q_d, k_d, v_d, gates = split_projection(h @ p['w_in'])

    y_f = fourier_mix(u_f) @ p['w_fou']

    q_g = q_g.reshape(b, t, GLA_HEADS, GLA_DK) * (GLA_DK ** -0.5)
    k_g = k_g.reshape(b, t, GLA_HEADS, GLA_DK)
    v_g = v_g.reshape(b, t, GLA_HEADS, GLA_DV)
    log_a = gla_log_gates(a_g, p['w_gla_a2'], p['b_gla_a'])
    s0 = jnp.zeros((b, 2, GLA_HEADS, GLA_DK, GLA_DV), jnp.float32) if ctx is None else ctx[0]
    o_g, s_fin = gla_bidirectional(q_g, k_g, v_g, log_a, s0)
    o_g = rms_norm(o_g.astype(x.dtype), p['gla_norm']) * jax.nn.silu(r_g.reshape(b, t, GLA_HEADS, GLA_DV))
    y_g = o_g.reshape(b, t, GLA_V) @ p['w_gla_o']

    q_d = rms_norm(q_d.reshape(b, t, DIFF_HEADS, 2, DIFF_HEAD_DIM), p['diff_qk_norm'][0])
    k_d = rms_norm(k_d.reshape(b, t, DIFF_HEADS, 2, DIFF_HEAD_DIM), p['diff_qk_norm'][1])
    v_d = v_d.reshape(b, t, DIFF_HEADS, DIFF_V_HEAD)
    lp = p['diff_lambda'].astype(jnp.float32)
    lam_init = 0.8 - 0.6 * math.exp(-0.3 * layer_idx)
    lam = jnp.exp(jnp.sum(lp[0] * lp[1])) - jnp.exp(jnp.sum(lp[2] * lp[3])) + lam_init
    if ctx is None:
        o_d = diff_attend(q_d, k_d, v_d, lam)
    else:
        cos, sin = rope
        keys = jnp.concatenate([apply_rope(k_d, cos, sin), ctx[1].astype(k_d.dtype)], axis=1)
        vals = jnp.concatenate([v_d, ctx[2].astype(v_d.dtype)], axis=1)
        o_d = diff_attend(apply_rope(q_d, cos, sin), keys, vals, lam)
    o_d = rms_norm(o_d, p['diff_norm']) * (1.0 - lam_init)
    y_d = o_d.reshape(b, t, DIFF_V) @ p['w_diff_o']

    gf, gg, gd = jnp.split(jax.nn.sigmoid(gates), N_BRANCH, axis=-1)
    merged = gf * y_f + gg * y_g + gd * y_d
    x = x + g1 * (merged @ p['w_out'])

    h2 = rms_norm(x, p['norm2']) * (1 + sc2) + sh2
    ff = (jax.nn.silu(h2 @ p['w_ff_gate']) * (h2 @ p['w_ff_up'])) @ p['w_ff_down']
    x = x + g2 * ff
    return x, s_fin, k_d, v_d


def setup_inputs(seed: int = 0) -> dict:
    key = jax.random.key(seed)
    ks = jax.random.split(key, 25)
    def nrm(k, shape, s=1.0):
        return jax.random.normal(k, shape, jnp.float32) * s
    D = D_MODEL
    return {
        'x_prompt': nrm(ks[0], (BATCH, SEQ, D)),
        'x_sample': nrm(ks[1], (DEC_BATCH, DEC_SEQ, D)),
        'c': nrm(ks[2], (DEC_BATCH, D)),
        'cache_diff_k': nrm(ks[3], (DEC_BATCH, DEPTH, PAST_LEN, DIFF_HEADS, 2, DIFF_HEAD_DIM)),
        'cache_diff_v': nrm(ks[4], (DEC_BATCH, DEPTH, PAST_LEN, DIFF_HEADS, DIFF_V_HEAD)),
        'state_gla': nrm(ks[5], (DEC_BATCH, DEPTH, 2, GLA_HEADS, GLA_DK, GLA_DV), 0.5),
        'c_ctx': nrm(ks[6], (D,)),
        'w_mod': nrm(ks[7], (DEPTH, D, 6 * D), 0.5 * D ** -0.5),
        'b_mod': nrm(ks[8], (DEPTH, 6 * D), 0.02),
        'norm1': 1.0 + nrm(ks[9], (DEPTH, D), 0.02),
        'norm2': 1.0 + nrm(ks[10], (DEPTH, D), 0.02),
        'w_in': nrm(ks[11], (DEPTH, D, IN_COLS), D ** -0.5),
        'w_gla_a2': nrm(ks[12], (DEPTH, 2, GATE_RANK, GLA_K), GATE_RANK ** -0.5),
        'b_gla_a': nrm(ks[13], (DEPTH, 2, GLA_K), 0.1),
        'gla_norm': 1.0 + nrm(ks[14], (DEPTH, GLA_DV), 0.02),
        'diff_qk_norm': 1.0 + nrm(ks[15], (DEPTH, 2, DIFF_HEAD_DIM), 0.02),
        'diff_lambda': nrm(ks[16], (DEPTH, 4, DIFF_HEAD_DIM), 0.1),
        'diff_norm': 1.0 + nrm(ks[17], (DEPTH, DIFF_V_HEAD), 0.02),
        'w_fou': nrm(ks[18], (DEPTH, FOU_W, D), FOU_W ** -0.5),
        'w_gla_o': nrm(ks[19], (DEPTH, GLA_V, D), GLA_V ** -0.5),
        'w_diff_o': nrm(ks[20], (DEPTH, DIFF_V, D), DIFF_V ** -0.5),
        'w_out': nrm(ks[21], (DEPTH, D, D), D ** -0.5),
        'w_ff_gate': nrm(ks[22], (DEPTH, D, D_FF), D ** -0.5),
        'w_ff_up': nrm(ks[23], (DEPTH, D, D_FF), D ** -0.5),
        'w_ff_down': nrm(ks[24], (DEPTH, D_FF, D), D_FF ** -0.5),
    }


def reference(x_prompt, x_sample, c, cache_diff_k, cache_diff_v, state_gla, c_ctx,
              w_mod, b_mod, norm1, norm2, w_in, w_gla_a2, b_gla_a, gla_norm,
              diff_qk_norm, diff_lambda, diff_norm, w_fou, w_gla_o, w_diff_o, w_out,
              w_ff_gate, w_ff_up, w_ff_down):
    def layer_params(l):
        return {
            'w_mod': w_mod[l], 'b_mod': b_mod[l], 'norm1': norm1[l], 'norm2': norm2[l],
            'w_in': w_in[l], 'w_gla_a2': w_gla_a2[l], 'b_gla_a': b_gla_a[l],
            'gla_norm': gla_norm[l], 'diff_qk_norm': diff_qk_norm[l],
            'diff_lambda': diff_lambda[l], 'diff_norm': diff_norm[l], 'w_fou': w_fou[l],
            'w_gla_o': w_gla_o[l], 'w_diff_o': w_diff_o[l], 'w_out': w_out[l],
            'w_ff_gate': w_ff_gate[l], 'w_ff_up': w_ff_up[l], 'w_ff_down': w_ff_down[l],
        }

    cond_ctx = c_ctx[None, :]
    y_prompt = x_prompt
    k_list, v_list, s_list = [], [], []
    for l in range(DEPTH):
        y_prompt, s_l, k_l, v_l = trunk_layer(y_prompt, cond_ctx, l, layer_params(l), None, None)
        s_list.append(s_l)
        k_list.append(k_l)
        v_list.append(v_l)

    rope = axial_rope(x_sample.shape[1])
    y_sample = x_sample
    for l in range(DEPTH):
        ctx = (state_gla[:, l], cache_diff_k[:, l], cache_diff_v[:, l])
        y_sample, _, _, _ = trunk_layer(y_sample, c, l, layer_params(l), rope, ctx)

    new_cache_diff_k = jnp.stack(k_list, axis=1)
    new_cache_diff_v = jnp.stack(v_list, axis=1)
    new_state_gla = jnp.stack(s_list, axis=1)
    return (y_prompt, y_sample, new_cache_diff_k, new_cache_diff_v, new_state_gla)
```

```cpp
#include <hip/hip_runtime.h>
#include <hip/hip_cooperative_groups.h>
#include <cstdio>
#include <cmath>
namespace cg = cooperative_groups;

#ifndef ONE_LAUNCH
#define ONE_LAUNCH 1
#endif

typedef unsigned short bf16_t;
typedef short bf16x8 __attribute__((ext_vector_type(8)));
typedef float f32x16 __attribute__((ext_vector_type(16)));
typedef unsigned u32x4 __attribute__((ext_vector_type(4)));
typedef unsigned u32x2 __attribute__((ext_vector_type(2)));
#define DI __device__ __forceinline__
#define LBAR() asm volatile("s_waitcnt lgkmcnt(0)\n\ts_barrier" ::: "memory")
#define MFMA32(a, b, c) __builtin_amdgcn_mfma_f32_32x32x16_bf16((a), (b), (c), 0, 0, 0)

constexpr int DM = 1024, NTOK = 36864, NCTXTOK = 4096, TL = 4096, TC = 256, NB_C = 16, NB_L = 8, DEPTH = 4;
constexpr int INC = 6688, DFF = 2816, KL = 4352;
constexpr int NWIN = 4224;
constexpr int NTH = 512;
constexpr int LDS_BYTES = 153600;

constexpr size_t al256(size_t x) { return (x + 255) & ~(size_t)255; }
constexpr size_t O_WIN = 0;
constexpr size_t O_WGT = O_WIN + (size_t)NWIN * 1024 * 2;
constexpr size_t O_WFOU = O_WGT + (size_t)3072 * 1024 * 2;
constexpr size_t O_WGO = O_WFOU + (size_t)1024 * 512 * 2;
constexpr size_t O_WDO = O_WGO + (size_t)1024 * 512 * 2;
constexpr size_t O_WOUT = O_WDO + (size_t)1024 * 512 * 2;
constexpr size_t O_WGU = O_WOUT + (size_t)1024 * 1024 * 2;
constexpr size_t O_WDN = O_WGU + (size_t)5632 * 1024 * 2;
constexpr size_t O_DL = O_WDN + (size_t)1024 * 2816 * 2;
constexpr size_t O_DC = O_DL + (size_t)4096 * 8192 * 2;
constexpr size_t O_HB = O_DC + (size_t)256 * 512 * 2;
constexpr size_t O_ZT = O_HB + (size_t)NTOK * 1024 * 2;
constexpr size_t O_QG = O_ZT + (size_t)NTOK * 1024 * 2;
constexpr size_t O_KG = O_QG + (size_t)NTOK * 256 * 2;
constexpr size_t O_VGT = O_KG + (size_t)NTOK * 256 * 2;
constexpr size_t O_RG = O_VGT + (size_t)NTOK * 512 * 2;
constexpr size_t O_AG = O_RG + (size_t)NTOK * 512 * 2;
constexpr size_t O_QD = O_AG + (size_t)NTOK * 32 * 4;
constexpr size_t O_KDL = O_QD + (size_t)NTOK * 512 * 2;
constexpr size_t O_KDC = O_KDL + (size_t)NB_L * KL * 512 * 2;
constexpr size_t O_VTL = O_KDC + (size_t)NB_C * 256 * 512 * 2;
constexpr size_t O_VTC = O_VTL + (size_t)NB_L * 512 * KL * 2;
constexpr size_t O_MOD = O_VTC + (size_t)NB_C * 512 * 256 * 2;
constexpr size_t O_MODP = O_ZT;
constexpr size_t O_OGB = O_MOD + (size_t)DEPTH * 9 * 6144 * 4;
constexpr size_t O_ROPE = O_OGB + (size_t)NTOK * 512 * 2;
constexpr size_t O_LAM = O_ROPE + (size_t)64 * 16 * 8;
constexpr size_t O_CNT = O_LAM + 256;
constexpr size_t O_BAR = O_CNT + 1024;
constexpr size_t WS_END = O_BAR + 2048;
constexpr size_t O_ACT = O_ZT;
constexpr size_t O_MG = O_QG;
static_assert(O_ACT + (size_t)NTOK * DFF * 2 <= O_KDL, "ACT alias overflow");

constexpr size_t OUT_CK = (size_t)NTOK * 1024;
constexpr size_t OUT_CV = OUT_CK + (size_t)16 * 4 * 256 * 512;
constexpr size_t OUT_ST = OUT_CV + (size_t)16 * 4 * 256 * 512;

struct Params {
    const float* in[25];
    float* out;
    unsigned char* ws;
    int ph_lo, ph_hi;
};

DI int get_tid() { int t = threadIdx.x; asm volatile("" : "+v"(t)); return t; }
DI int get_nblk() { int b = gridDim.x; asm volatile("" : "+s"(b)); return b; }
DI int get_bid() { int b = blockIdx.x; asm volatile("" : "+s"(b)); return b; }
typedef __bf16 bf16v2 __attribute__((ext_vector_type(2)));
typedef float f32v2 __attribute__((ext_vector_type(2)));
DI unsigned pk2(float lo, float hi) { f32v2 v = {lo, hi}; return __builtin_bit_cast(unsigned, __builtin_convertvector(v, bf16v2)); }
DI unsigned bfbits(float x) { return pk2(x, 0.f) & 0xffffu; }
#define GAS __attribute__((address_space(1)))
DI u32x4 gld16(const void* p) { return *(const GAS u32x4*)p; }
DI void st_pair16_if(bf16_t* p, u32x2 a, u32x2 b, int lh, bool ok) {
    const auto r = __builtin_amdgcn_permlane32_swap(a.x, b.x, false, false);
    const auto q = __builtin_amdgcn_permlane32_swap(a.y, b.y, false, false);
    u32x4 v; v.x = r[0]; v.y = q[0]; v.z = r[1]; v.w = q[1];
    if (ok) *(u32x4*)(p + lh * 8) = v;
}
DI void st_pair16(bf16_t* p, u32x2 a, u32x2 b, int lh) {
    const auto r = __builtin_amdgcn_permlane32_swap(a.x, b.x, false, false);
    const auto q = __builtin_amdgcn_permlane32_swap(a.y, b.y, false, false);
    u32x4 v; v.x = r[0]; v.y = q[0]; v.z = r[1]; v.w = q[1];
    *(u32x4*)(p + lh * 8) = v;
}
DI float bf2f(unsigned b) { return __uint_as_float(b << 16); }
DI float wave_sum(float v) {
#pragma unroll
    for (int o = 1; o < 64; o <<= 1) v += __shfl_xor(v, o);
    return v;
}
DI float sigmoidf_(float x) { return 1.f / (1.f + __expf(-x)); }
DI float siluf_(float x) { return x / (1.f + __expf(-x)); }
DI float lam_init_f(int l) { return 0.8f - 0.6f * __expf(-0.3f * (float)l); }
DI int tok_r(int tok) { return tok < NCTXTOK ? 0 : 1 + ((tok - NCTXTOK) >> 12); }
DI int tok_batch0(int tok) { return tok < NCTXTOK ? (tok & ~255) : NCTXTOK + ((tok - NCTXTOK) & ~4095); }
DI const float* xrow_ptr(const Params& p, int layer, int tok) {
    const float* x0 = p.in[0]; const float* x1 = p.in[1]; const float* xo = p.out;
    const float* base = layer == 0 ? (tok < NCTXTOK ? x0 : x1) : xo;
    const size_t row = layer == 0 ? (size_t)(tok < NCTXTOK ? tok : tok - NCTXTOK) : (size_t)tok;
    return base + row * 1024;
}

constexpr int G_PITCH = 144;
constexpr int G_ASZ = 256 * G_PITCH, G_BSZ = 128 * G_PITCH, G_STAGE = G_ASZ + G_BSZ;

struct ALoadBF {
    const bf16_t* A; int lda;
    DI void load4(u32x4 (&ra)[4], int crow, int k) const {
#pragma unroll
        for (int i = 0; i < 4; ++i) ra[i] = gld16(A + (size_t)(crow + 64 * i) * lda + k);
    }
};
template <int NT, bool DB = true, class AL>
DI void gemm_kloop(f32x16 (&acc)[2][NT], const AL& al, const bf16_t* Bt, int ldb, int K, unsigned char* lds) {
    const int tid = get_tid(), lane = tid & 63, w = tid >> 6, wm = w >> 1, wn = w & 1;
    const int crow = tid >> 3, ck = (tid & 7) * 8;
    constexpr int STG = G_ASZ + 64 * NT * G_PITCH;
    u32x4 ra[4], rb[NT];
    int nk_ = K >> 6; asm volatile("" : "+s"(nk_));
    const int nk = nk_;
    __syncthreads();
    al.load4(ra, crow, ck);
#pragma unroll
    for (int i = 0; i < NT; ++i) rb[i] = gld16(Bt + (size_t)(crow + 64 * i) * ldb + ck);
#pragma unroll
    for (int i = 0; i < 4; ++i) *(u32x4*)(lds + (crow + 64 * i) * G_PITCH + ck * 2) = ra[i];
#pragma unroll
    for (int i = 0; i < NT; ++i) *(u32x4*)(lds + G_ASZ + (crow + 64 * i) * G_PITCH + ck * 2) = rb[i];
    if (nk > 1) {
        al.load4(ra, crow, 64 + ck);
#pragma unroll
        for (int i = 0; i < NT; ++i) rb[i] = gld16(Bt + (size_t)(crow + 64 * i) * ldb + 64 + ck);
    }
    LBAR();
    const int aoff = (wm * 64 + (lane & 31)) * G_PITCH + (lane >> 5) * 16;
    const int boff = G_ASZ + (wn * 32 * NT + (lane & 31)) * G_PITCH + (lane >> 5) * 16;
    for (int kt = 0; kt < nk; ++kt) {
        unsigned char* cur = lds + (kt & 1) * STG;
        unsigned char* nxt = lds + ((kt + 1) & 1) * STG;
        if constexpr (!DB) {
        if (kt + 1 < nk) {
#pragma unroll
            for (int i = 0; i < 4; ++i) *(u32x4*)(nxt + (crow + 64 * i) * G_PITCH + ck * 2) = ra[i];
#pragma unroll
            for (int i = 0; i < NT; ++i) *(u32x4*)(nxt + G_ASZ + (crow + 64 * i) * G_PITCH + ck * 2) = rb[i];
        }
        if (kt + 2 < nk) {
            const int k0 = (kt + 2) * 64 + ck;
            al.load4(ra, crow, k0);
#pragma unroll
            for (int i = 0; i < NT; ++i) rb[i] = gld16(Bt + (size_t)(crow + 64 * i) * ldb + k0);
        }
        __builtin_amdgcn_sched_barrier(0);
        }
        if constexpr (DB) {
        bf16x8 af[2][2], bfr[2][NT];
#pragma unroll
        for (int mt = 0; mt < 2; ++mt) af[0][mt] = *(const bf16x8*)(cur + aoff + mt * 32 * G_PITCH);
#pragma unroll
        for (int nt = 0; nt < NT; ++nt) bfr[0][nt] = *(const bf16x8*)(cur + boff + nt * 32 * G_PITCH);
#pragma unroll
        for (int ks = 0; ks < 4; ++ks) {
            if (ks < 3) {
#pragma unroll
                for (int mt = 0; mt < 2; ++mt) af[(ks + 1) & 1][mt] = *(const bf16x8*)(cur + aoff + mt * 32 * G_PITCH + (ks + 1) * 32);
#pragma unroll
                for (int nt = 0; nt < NT; ++nt) bfr[(ks + 1) & 1][nt] = *(const bf16x8*)(cur + boff + nt * 32 * G_PITCH + (ks + 1) * 32);
            }
            if (ks == 1) {
                __builtin_amdgcn_sched_barrier(0x10E);
                if (kt + 1 < nk) {
#pragma unroll
                    for (int i = 0; i < 4; ++i) *(u32x4*)(nxt + (crow + 64 * i) * G_PITCH + ck * 2) = ra[i];
#pragma unroll
                    for (int i = 0; i < NT; ++i) *(u32x4*)(nxt + G_ASZ + (crow + 64 * i) * G_PITCH + ck * 2) = rb[i];
                }
                if (kt + 2 < nk) {
                    const int k0 = (kt + 2) * 64 + ck;
                    al.load4(ra, crow, k0);
#pragma unroll
                    for (int i = 0; i < NT; ++i) rb[i] = gld16(Bt + (size_t)(crow + 64 * i) * ldb + k0);
                }
                __builtin_amdgcn_sched_barrier(0x10E);
            }
            __builtin_amdgcn_s_setprio(1);
#pragma unroll
            for (int mt = 0; mt < 2; ++mt)
#pragma unroll
                for (int nt = 0; nt < NT; ++nt) acc[mt][nt] = MFMA32(bfr[ks & 1][nt], af[ks & 1][mt], acc[mt][nt]);
            __builtin_amdgcn_s_setprio(0);
        }
        } else {
#pragma unroll
        for (int ks = 0; ks < 4; ++ks) {
            bf16x8 af[2], bfr[NT];
#pragma unroll
            for (int mt = 0; mt < 2; ++mt) af[mt] = *(const bf16x8*)(cur + aoff + mt * 32 * G_PITCH + ks * 32);
#pragma unroll
            for (int nt = 0; nt < NT; ++nt) bfr[nt] = *(const bf16x8*)(cur + boff + nt * 32 * G_PITCH + ks * 32);
#pragma unroll
            for (int mt = 0; mt < 2; ++mt)
#pragma unroll
                for (int nt = 0; nt < NT; ++nt) acc[mt][nt] = MFMA32(bfr[nt], af[mt], acc[mt][nt]);
            asm volatile("" ::: "memory");
        }
        }
        LBAR();
    }
}
template <int NT>
DI void acc_zero(f32x16 (&acc)[2][NT]) {
#pragma unroll
    for (int a = 0; a < 2; ++a)
#pragma unroll
        for (int b = 0; b < NT; ++b)
#pragma unroll
            for (int r = 0; r < 16; ++r) acc[a][b][r] = 0.f;
}

DI void transpose_item(const float* src, int ld, int K, int srccol, bf16_t* dst, int dstrow, int k0, float* scr, int lane, bool zero) {
#pragma unroll 8
    for (int i = 0; i < 32; ++i) { const int kk = 2 * i + (lane >> 5); scr[kk * 33 + (lane & 31)] = zero ? 0.f : src[(size_t)(k0 + kk) * ld + srccol + (lane & 31)]; }
    asm volatile("s_waitcnt lgkmcnt(0)" ::: "memory");
    const int c = lane & 7;
#pragma unroll
    for (int j = 0; j < 4; ++j) {
        const int n = (lane >> 3) + 8 * j; const float* s = scr + (8 * c) * 33 + n;
        u32x4 o; o.x = pk2(s[0], s[33]); o.y = pk2(s[66], s[99]); o.z = pk2(s[132], s[165]); o.w = pk2(s[198], s[231]);
        *(u32x4*)(dst + (size_t)(dstrow + n) * K + k0 + 8 * c) = o;
    }
    asm volatile("s_waitcnt lgkmcnt(0)" ::: "memory");
}

DI void convert_weights(const Params& p, int l, unsigned char* lds) {
    const int tid = get_tid(), lane = tid & 63, w = tid >> 6;
    float* scr = (float*)(lds + w * 8704);
    const int gw = get_bid() * 8 + w, ngw = get_nblk() * 8;
    __syncthreads();
    unsigned char* ws = p.ws;
    const float* w_in = p.in[11] + (size_t)l * 1024 * INC;
    const float* pw18 = p.in[18]; const float* pw19 = p.in[19]; const float* pw20 = p.in[20]; const float* pw22 = p.in[22]; const float* pw23 = p.in[23];
    constexpr int I_WIN = (NWIN - 1024) / 32 * 16;
    constexpr int I_WGT = 3072 / 32 * 16;
    constexpr int I_BR = 1024 / 32 * 8;
    constexpr int I_OUT = 1024 / 32 * 16;
    constexpr int I_GU = 5632 / 32 * 16;
    constexpr int I_DN = 1024 / 32 * 44;
    constexpr int NIT = I_WIN + I_WGT + 3 * I_BR + I_OUT + I_GU + I_DN;
    for (int it = gw; it < NIT; it += ngw) {
        int r = it;
        if (r < I_WIN) { const int rb = r / 16, kb = r % 16; const int prow = 1024 + rb * 32;
            const bool zero = (prow >= 2592 && prow < 2688); const int sc = prow < 2592 ? prow - 512 : prow - 608;
            transpose_item(w_in, INC, 1024, sc, (bf16_t*)(ws + O_WIN), prow, kb * 64, scr, lane, zero); continue; }
        r -= I_WIN;
        if (r < I_WGT) { const int rb = r / 16, kb = r % 16; transpose_item(w_in, INC, 1024, 3616 + rb * 32, (bf16_t*)(ws + O_WGT), rb * 32, kb * 64, scr, lane, false); continue; }
        r -= I_WGT;
        if (r < 3 * I_BR) { const int m = r / I_BR, q = r % I_BR, rb = q / 8, kb = q % 8;
            const float* src = (m == 0 ? pw18 : (m == 1 ? pw19 : pw20)) + (size_t)l * 512 * 1024;
            bf16_t* dst = (bf16_t*)(ws + (m == 0 ? O_WFOU : (m == 1 ? O_WGO : O_WDO)));
            transpose_item(src, 1024, 512, rb * 32, dst, rb * 32, kb * 64, scr, lane, false); continue; }
        r -= 3 * I_BR;
        if (r < I_OUT) { const int rb = r / 16, kb = r % 16; transpose_item(p.in[21] + (size_t)l * 1024 * 1024, 1024, 1024, rb * 32, (bf16_t*)(ws + O_WOUT), rb * 32, kb * 64, scr, lane, false); continue; }
        r -= I_OUT;
        if (r < I_GU) { const int rb = r / 16, kb = r % 16; const int prow = rb * 32; const int jt = prow >> 7, q = prow & 127, wn = q >> 6, nt = (q & 63) >> 5;
            const float* src = (nt ? pw23 : pw22) + (size_t)l * 1024 * DFF;
            transpose_item(src, DFF, 1024, jt * 64 + wn * 32, (bf16_t*)(ws + O_WGU), prow, kb * 64, scr, lane, false); continue; }
        r -= I_GU;
        { const int rb = r / 44, kb = r % 44; transpose_item(p.in[24] + (size_t)l * DFF * 1024, 1024, DFF, rb * 32, (bf16_t*)(ws + O_WDN), rb * 32, kb * 64, scr, lane, false); }
    }
    __syncthreads();
    float* wt = (float*)lds;
    float* tc = (float*)(lds + 64 * 129 * 4);
    for (int it = get_bid(); it < 64; it += get_nblk()) {
        const int g = it >> 4, kb = it & 15;
        __syncthreads();
        if (tid < 128) { const float fr = (float)tid * (1.f / 128.f); tc[tid] = __builtin_amdgcn_cosf(fr) * 0.08838834764831845f; tc[128 + tid] = __builtin_amdgcn_sinf(fr) * 0.08838834764831845f; }
        for (int e = tid; e < 64 * 128; e += NTH) { const int kk = e >> 7, c = e & 127; wt[kk * 129 + c] = w_in[(size_t)(kb * 64 + kk) * INC + g * 128 + c]; }
        __syncthreads();
        const int kk = tid & 63;
        for (int o = tid >> 6; o < 256; o += 8) {
            const int part = o >> 7, j = o & 127; float s = 0.f;
            for (int c = 0; c < 128; ++c) s += wt[kk * 129 + c] * tc[part * 128 + ((c * j) & 127)];
            ((bf16_t*)(ws + O_WIN))[(size_t)(part * 512 + g * 128 + j) * 1024 + kb * 64 + kk] = (bf16_t)bfbits(s);
        }
    }
    __syncthreads();
}

DI void convert_cache(const Params& p, int l) {
    const int gt = get_bid() * NTH + get_tid(), ng = get_nblk() * NTH;
    bf16_t* KDLp = (bf16_t*)(p.ws + O_KDL); bf16_t* VTLp = (bf16_t*)(p.ws + O_VTL);
    for (int e = gt; e < NB_L * 256 * 128; e += ng) {
        const int b = e / (256 * 128), r = e % (256 * 128), pos = r >> 7, c4 = (r & 127) * 4;
        const float4 v = *(const float4*)(p.in[3] + (((size_t)b * DEPTH + l) * 256 + pos) * 512 + c4);
        u32x2 o; o.x = pk2(v.x, v.y); o.y = pk2(v.z, v.w);
        *(u32x2*)(KDLp + ((size_t)b * KL + 4096 + pos) * 512 + c4) = o;
    }
    for (int e = gt; e < NB_L * 512 * 256; e += ng) {
        const int b = e / (512 * 256), r = e % (512 * 256), col = r >> 8, pos = r & 255;
        const float v = p.in[4][(((size_t)b * DEPTH + l) * 256 + pos) * 512 + col];
        VTLp[((size_t)b * 512 + col) * KL + 4096 + pos] = (bf16_t)bfbits(v);
    }
}

DI void phase_prep(const Params& p, unsigned char* lds) {
    const int tid = get_tid();
    unsigned char* ws = p.ws;
    {
        float* sl = (float*)lds;
        for (int it = get_bid(); it < DEPTH * 16 * 12; it += get_nblk()) {
            const int l = it / 192, q = it % 192, kc = q / 12, nb = q % 12;
            __syncthreads();
            for (int e = tid; e < 9 * 64; e += NTH) { const int r = e >> 6, k = kc * 64 + (e & 63); const float c = r == 0 ? p.in[6][k] : p.in[2][(r - 1) * 1024 + k]; sl[e] = siluf_(c); }
            __syncthreads();
            const int n = nb * 512 + tid; float a[9];
#pragma unroll
            for (int r = 0; r < 9; ++r) a[r] = 0.f;
            const float* wm = p.in[7] + ((size_t)l * 1024 + kc * 64) * 6144 + n;
#pragma unroll 4
            for (int k = 0; k < 64; ++k) { const float wv = wm[(size_t)k * 6144];
#pragma unroll
                for (int r = 0; r < 9; ++r) a[r] += sl[r * 64 + k] * wv; }
            float* mp = (float*)(ws + O_MODP) + (((size_t)kc * DEPTH + l) * 9) * 6144 + n;
#pragma unroll
            for (int r = 0; r < 9; ++r) mp[(size_t)r * 6144] = a[r];
        }
    }
    {
        const int gt = get_bid() * NTH + tid, ng = get_nblk() * NTH;
        bf16_t* DLp = (bf16_t*)(ws + O_DL);
        for (int e = gt; e < 2048 * 1024; e += ng) {
            const int s = e >> 10, t8 = (e & 1023) * 8; float v[8];
#pragma unroll
            for (int j = 0; j < 8; ++j) { const int t = t8 + j; const int tt = t & 4095; const float fr = (float)((s * tt) & 4095) * (1.f / 4096.f);
                v[j] = (t < 4096 ? __builtin_amdgcn_cosf(fr) : -__builtin_amdgcn_sinf(fr)) * (1.f / 64.f); }
            u32x4 o; o.x = pk2(v[0], v[1]); o.y = pk2(v[2], v[3]); o.z = pk2(v[4], v[5]); o.w = pk2(v[6], v[7]);
            *(u32x4*)(DLp + (size_t)s * 8192 + t8) = o;
        }
        bf16_t* DCp = (bf16_t*)(ws + O_DC);
        for (int e = gt; e < 256 * 512; e += ng) {
            const int s = e >> 9, t = e & 511, tt = t & 255; const float fr = (float)((s * tt) & 255) * (1.f / 256.f);
            DCp[e] = (bf16_t)bfbits((t < 256 ? __builtin_amdgcn_cosf(fr) : -__builtin_amdgcn_sinf(fr)) * (1.f / 16.f));
        }
        float2* rope = (float2*)(ws + O_ROPE);
        for (int e = gt; e < 1024; e += ng) {
            const int pos = e >> 4, f = e & 15; const float ang = (float)pos * exp2f(-(float)f * 0.8304820237218406f);
            double rev = (double)ang * 0.15915494309189535; rev -= floor(rev); const float fr = (float)rev;
            rope[e] = make_float2(__builtin_amdgcn_cosf(fr), __builtin_amdgcn_sinf(fr));
        }
        if (gt < DEPTH) {
            const float* lp = p.in[16] + gt * 256; float s1 = 0.f, s2 = 0.f;
            for (int i = 0; i < 64; ++i) { s1 += lp[i] * lp[64 + i]; s2 += lp[128 + i] * lp[192 + i]; }
            ((float*)(ws + O_LAM))[gt] = expf(s1) - expf(s2) + lam_init_f(gt);
        }
    }
    convert_weights(p, 0, lds);
    convert_cache(p, 0);
}

DI void phase_modreduce(const Params& p) {
    const int gt = get_bid() * NTH + get_tid(), ng = get_nblk() * NTH;
    float* mod = (float*)(p.ws + O_MOD); const float* mp = (const float*)(p.ws + O_MODP);
    for (int e = gt; e < DEPTH * 9 * 6144; e += ng) {
        const int l = e / (9 * 6144), n = e % 6144; float s = p.in[8][l * 6144 + n];
        for (int kc = 0; kc < 16; ++kc) s += mp[(size_t)kc * DEPTH * 9 * 6144 + e];
        mod[e] = s;
    }
}

DI void phase_norm(const Params& p, int l, int which, size_t dst_off) {
    const int lane = get_tid() & 63, gw = get_bid() * 8 + (get_tid() >> 6), ngw = get_nblk() * 8;
    const float* n9 = p.in[9]; const float* n10 = p.in[10]; const float* nw = (which ? n10 : n9) + l * 1024;
    const float* mod = (const float*)(p.ws + O_MOD) + (size_t)l * 9 * 6144;
    bf16_t* HB = (bf16_t*)(p.ws + dst_off);
    u32x4 vn[4];
    if (gw < NTOK) { const float* xr = which ? p.out + (size_t)gw * 1024 : xrow_ptr(p, l, gw);
#pragma unroll
        for (int j = 0; j < 4; ++j) vn[j] = gld16(xr + j * 256 + lane * 4); }
    for (int tok = gw; tok < NTOK; tok += ngw) {
        u32x4 vc[4];
#pragma unroll
        for (int j = 0; j < 4; ++j) vc[j] = vn[j];
        if (tok + ngw < NTOK) { const int tn = tok + ngw; const float* xr = which ? p.out + (size_t)tn * 1024 : xrow_ptr(p, l, tn);
#pragma unroll
            for (int j = 0; j < 4; ++j) vn[j] = gld16(xr + j * 256 + lane * 4); }
        const float* mr = mod + (size_t)tok_r(tok) * 6144 + (which ? 3072 : 0);
        float4 v[4]; float s = 0.f;
#pragma unroll
        for (int j = 0; j < 4; ++j) { v[j] = make_float4(__uint_as_float(vc[j].x), __uint_as_float(vc[j].y), __uint_as_float(vc[j].z), __uint_as_float(vc[j].w));
            s += v[j].x * v[j].x + v[j].y * v[j].y + v[j].z * v[j].z + v[j].w * v[j].w; }
        s = wave_sum(s); const float rstd = rsqrtf(s * (1.f / 1024.f) + 1e-6f);
#pragma unroll
        for (int j = 0; j < 4; ++j) {
            const int k = j * 256 + lane * 4;
            const float4 g = *(const float4*)(nw + k), sh = *(const float4*)(mr + k), sc = *(const float4*)(mr + 1024 + k);
            u32x2 o; o.x = pk2(v[j].x * rstd * g.x * (1.f + sc.x) + sh.x, v[j].y * rstd * g.y * (1.f + sc.y) + sh.y);
            o.y = pk2(v[j].z * rstd * g.z * (1.f + sc.z) + sh.z, v[j].w * rstd * g.w * (1.f + sc.w) + sh.w);
            *(u32x2*)(HB + (size_t)tok * 1024 + k) = o;
        }
    }
}

DI void g1_tile(const Params& p, int l, int mtile, int ntile, unsigned char* lds) {
    const int tid = get_tid(), lane = tid & 63, w = tid >> 6, wm = w >> 1, wn = w & 1, lh = lane >> 5, l31 = lane & 31;
    unsigned char* ws = p.ws;
    f32x16 acc[2][4]; acc_zero<4>(acc);
    const int m0 = mtile * 256;
    ALoadBF al{(const bf16_t*)(ws + O_HB) + (size_t)m0 * 1024, 1024};
    gemm_kloop<4>(acc, al, (const bf16_t*)(ws + O_WIN) + (size_t)ntile * 256 * 1024, 1024, 1024, lds);
    const bool ctx = m0 < NCTXTOK;
    const int tb0 = tok_batch0(m0);
    const int T = ctx ? TC : TL;
    const int bidx = ctx ? (m0 >> 8) : ((m0 - NCTXTOK) >> 12);
#pragma unroll
    for (int pr = 0; pr < 2; ++pr) {
    const int colbase = ntile * 256 + wn * 128 + pr * 64; const int seg = colbase >> 7; const int n0 = seg * 128; const int wn_ = (colbase >> 6) & 1;
    if (seg < 8) {
        bf16_t* zt = (bf16_t*)(ws + O_ZT) + (size_t)tb0 * 1024;
#pragma unroll
        for (int mt = 0; mt < 2; ++mt) { const int t = m0 + wm * 64 + mt * 32 + l31 - tb0;
#pragma unroll
            for (int nt = 0; nt < 2; ++nt)
#pragma unroll
                for (int r = 0; r < 16; ++r) { const int c = n0 + wn_ * 64 + nt * 32 + (r >> 2) * 8 + lh * 4 + (r & 3); const int part = c >> 9, n = c & 511;
                    zt[(size_t)n * (2 * T) + part * T + t] = (bf16_t)bfbits(acc[mt][2 * pr + nt][r]); } }
    } else if (seg < 12 || (seg >= 16 && seg < 20)) {
        bf16_t* dst; int cb, ld; float sc = 1.f;
        if (seg < 10) { dst = (bf16_t*)(ws + O_QG); cb = n0 - 1024; ld = 256; sc = 0.125f; }
        else if (seg < 12) { dst = (bf16_t*)(ws + O_KG); cb = n0 - 1280; ld = 256; }
        else { dst = (bf16_t*)(ws + O_RG); cb = n0 - 2048; ld = 512; }
#pragma unroll
        for (int mt = 0; mt < 2; ++mt) { const int row = m0 + wm * 64 + mt * 32 + l31;
#pragma unroll
            for (int nt = 0; nt < 2; ++nt)
#pragma unroll
                for (int gp = 0; gp < 2; ++gp) { const int c = cb + wn_ * 64 + nt * 32 + gp * 16; const int g0 = 2 * gp, g1 = 2 * gp + 1; u32x2 oa, ob;
                    oa.x = pk2(acc[mt][2 * pr + nt][4 * g0] * sc, acc[mt][2 * pr + nt][4 * g0 + 1] * sc); oa.y = pk2(acc[mt][2 * pr + nt][4 * g0 + 2] * sc, acc[mt][2 * pr + nt][4 * g0 + 3] * sc);
                    ob.x = pk2(acc[mt][2 * pr + nt][4 * g1] * sc, acc[mt][2 * pr + nt][4 * g1 + 1] * sc); ob.y = pk2(acc[mt][2 * pr + nt][4 * g1 + 2] * sc, acc[mt][2 * pr + nt][4 * g1 + 3] * sc);
                    st_pair16(dst + (size_t)row * ld + c, oa, ob, lh); } }
    } else if (seg < 16) {
        bf16_t* vt = (bf16_t*)(ws + O_VGT) + (size_t)tb0 * 512;
#pragma unroll
        for (int mt = 0; mt < 2; ++mt) { const int t = m0 + wm * 64 + mt * 32 + l31 - tb0;
#pragma unroll
            for (int nt = 0; nt < 2; ++nt)
#pragma unroll
                for (int r = 0; r < 16; ++r) { const int c = n0 - 1536 + wn_ * 64 + nt * 32 + (r >> 2) * 8 + lh * 4 + (r & 3);
                    vt[(size_t)c * T + t] = (bf16_t)bfbits(acc[mt][2 * pr + nt][r]); } }
    } else if (seg == 20) {
        if (wn_ == 0) { float* ag = (float*)(ws + O_AG);
#pragma unroll
            for (int mt = 0; mt < 2; ++mt) { const int row = m0 + wm * 64 + mt * 32 + l31;
#pragma unroll
                for (int g = 0; g < 4; ++g) { const int c = g * 8 + lh * 4;
                    *(float4*)(ag + (size_t)row * 32 + c) = make_float4(acc[mt][2 * pr][4 * g], acc[mt][2 * pr][4 * g + 1], acc[mt][2 * pr][4 * g + 2], acc[mt][2 * pr][4 * g + 3]); } } }
    } else if (seg < 29) {
        const bool isq = seg < 25;
        const int cb = (isq ? n0 - 2688 : n0 - 3200) + wn_ * 64;
        const float* gain = p.in[15] + (l * 2 + (isq ? 0 : 1)) * 64;
        const float2* rope = (const float2*)(ws + O_ROPE);
#pragma unroll
        for (int mt = 0; mt < 2; ++mt) {
            const int row = m0 + wm * 64 + mt * 32 + l31; const int t = row - tb0;
            float ss = 0.f;
#pragma unroll
            for (int nt = 0; nt < 2; ++nt)
#pragma unroll
                for (int r = 0; r < 16; ++r) ss += acc[mt][2 * pr + nt][r] * acc[mt][2 * pr + nt][r];
            ss += __shfl_xor(ss, 32);
            const float rstd = rsqrtf(ss * (1.f / 64.f) + 1e-6f);
            float y[2][16];
#pragma unroll
            for (int nt = 0; nt < 2; ++nt)
#pragma unroll
                for (int r = 0; r < 16; ++r) { const int d = nt * 32 + (r >> 2) * 8 + lh * 4 + (r & 3); y[nt][r] = acc[mt][2 * pr + nt][r] * rstd * gain[d]; }
            if (!ctx) {
#pragma unroll
                for (int nt = 0; nt < 2; ++nt) { const int pos = nt == 0 ? (t >> 6) : (t & 63);
#pragma unroll
                    for (int r = 0; r < 8; ++r) { const int f = ((r >> 2) & 1) * 8 + lh * 4 + (r & 3); const float2 cs = rope[pos * 16 + f];
                        const float y0 = y[nt][r], y1 = y[nt][r + 8]; y[nt][r] = y0 * cs.x - y1 * cs.y; y[nt][r + 8] = y1 * cs.x + y0 * cs.y; } }
            }
            if (isq) {
                bf16_t* qd = (bf16_t*)(ws + O_QD) + (size_t)row * 512 + cb; const float qs = 0.125f * 1.4426950408889634f;
#pragma unroll
                for (int nt = 0; nt < 2; ++nt)
#pragma unroll
                    for (int gp = 0; gp < 2; ++gp) { const int g0 = 2 * gp, g1 = 2 * gp + 1; u32x2 oa, ob;
                        oa.x = pk2(y[nt][4 * g0] * qs, y[nt][4 * g0 + 1] * qs); oa.y = pk2(y[nt][4 * g0 + 2] * qs, y[nt][4 * g0 + 3] * qs);
                        ob.x = pk2(y[nt][4 * g1] * qs, y[nt][4 * g1 + 1] * qs); ob.y = pk2(y[nt][4 * g1 + 2] * qs, y[nt][4 * g1 + 3] * qs);
                        st_pair16(qd + nt * 32 + gp * 16, oa, ob, lh); }
            } else {
                bf16_t* kd = ctx ? (bf16_t*)(ws + O_KDC) + ((size_t)bidx * 256 + t) * 512 + cb : (bf16_t*)(ws + O_KDL) + ((size_t)bidx * KL + t) * 512 + cb;
#pragma unroll
                for (int nt = 0; nt < 2; ++nt)
#pragma unroll
                    for (int gp = 0; gp < 2; ++gp) { const int g0 = 2 * gp, g1 = 2 * gp + 1; u32x2 oa, ob;
                        oa.x = pk2(y[nt][4 * g0], y[nt][4 * g0 + 1]); oa.y = pk2(y[nt][4 * g0 + 2], y[nt][4 * g0 + 3]);
                        ob.x = pk2(y[nt][4 * g1], y[nt][4 * g1 + 1]); ob.y = pk2(y[nt][4 * g1 + 2], y[nt][4 * g1 + 3]);
                        st_pair16(kd + nt * 32 + gp * 16, oa, ob, lh); }
                if (ctx) { float* ok = p.out + OUT_CK + (((size_t)bidx * DEPTH + l) * 256 + t) * 512 + cb;
#pragma unroll
                    for (int nt = 0; nt < 2; ++nt)
#pragma unroll
                        for (int g = 0; g < 4; ++g) *(float4*)(ok + nt * 32 + g * 8 + lh * 4) = make_float4(y[nt][4 * g], y[nt][4 * g + 1], y[nt][4 * g + 2], y[nt][4 * g + 3]); }
            }
        }
    } else if (seg < 33) {
        const int Tk = ctx ? 256 : KL;
        bf16_t* vt = ctx ? (bf16_t*)(ws + O_VTC) + (size_t)bidx * 512 * 256 : (bf16_t*)(ws + O_VTL) + (size_t)bidx * 512 * KL;
#pragma unroll
        for (int mt = 0; mt < 2; ++mt) { const int row = m0 + wm * 64 + mt * 32 + l31; const int t = row - tb0;
#pragma unroll
            for (int nt = 0; nt < 2; ++nt) {
#pragma unroll
                for (int r = 0; r < 16; ++r) { const int c = n0 - 3712 + wn_ * 64 + nt * 32 + (r >> 2) * 8 + lh * 4 + (r & 3);
                    vt[(size_t)c * Tk + t] = (bf16_t)bfbits(acc[mt][2 * pr + nt][r]); }
                if (ctx) { float* ov = p.out + OUT_CV + (((size_t)bidx * DEPTH + l) * 256 + t) * 512 + (n0 - 3712) + wn_ * 64 + nt * 32;
#pragma unroll
                    for (int g = 0; g < 4; ++g) *(float4*)(ov + g * 8 + lh * 4) = make_float4(acc[mt][2 * pr + nt][4 * g], acc[mt][2 * pr + nt][4 * g + 1], acc[mt][2 * pr + nt][4 * g + 2], acc[mt][2 * pr + nt][4 * g + 3]); }
            } }
    }
    }
}

DI void dft_tile(const Params& p, bool ctx, int b, int mt_, int nt_, unsigned char* lds) {
    const int tid = get_tid(), lane = tid & 63, w = tid >> 6, wm = w >> 1, wn = w & 1, lh = lane >> 5, l31 = lane & 31;
    unsigned char* ws = p.ws;
    const int T = ctx ? TC : TL; const int tb0 = ctx ? b * 256 : NCTXTOK + b * 4096;
    f32x16 acc[2][2]; acc_zero<2>(acc);
    ALoadBF al{(const bf16_t*)(ws + (ctx ? O_DC : O_DL)) + (size_t)mt_ * 256 * (2 * T), 2 * T};
    gemm_kloop<2, false>(acc, al, (const bf16_t*)(ws + O_ZT) + (size_t)tb0 * 1024 + (size_t)nt_ * 128 * (2 * T), 2 * T, 2 * T, lds);
    bf16_t* yf = (bf16_t*)(ws + O_HB);
#pragma unroll
    for (int mt = 0; mt < 2; ++mt) { const int row = tb0 + mt_ * 256 + wm * 64 + mt * 32 + l31;
#pragma unroll
        for (int nt = 0; nt < 2; ++nt)
#pragma unroll
            for (int g = 0; g < 4; ++g) { const int c = nt_ * 128 + wn * 64 + nt * 32 + g * 8 + lh * 4;
                u32x2 o; o.x = pk2(acc[mt][nt][4 * g], acc[mt][nt][4 * g + 1]); o.y = pk2(acc[mt][nt][4 * g + 2], acc[mt][nt][4 * g + 3]);
                *(u32x2*)(yf + (size_t)row * 512 + c) = o; } }
}

DI void dft_lat_tile(const Params& p, int b, int mt_, int nt_, unsigned char* lds) {
    const int tid = get_tid(), lane = tid & 63, w = tid >> 6, wm = w >> 1, wn = w & 1, lh = lane >> 5, l31 = lane & 31;
    unsigned char* ws = p.ws;
    const int tb0 = NCTXTOK + b * 4096;
    const bf16_t* D = (const bf16_t*)(ws + O_DL) + (size_t)mt_ * 256 * 8192;
    const bf16_t* Z = (const bf16_t*)(ws + O_ZT) + (size_t)tb0 * 1024 + (size_t)nt_ * 128 * 8192;
    bf16_t* yf = (bf16_t*)(ws + O_HB);
    f32x16 ac[2][2], as[2][2]; acc_zero<2>(ac); acc_zero<2>(as);
    { ALoadBF alc{D, 8192}; gemm_kloop<2>(ac, alc, Z, 8192, 4096, lds); }
    { ALoadBF als{D + 4096, 8192}; gemm_kloop<2>(as, als, Z + 4096, 8192, 4096, lds); }
#pragma unroll
    for (int mt = 0; mt < 2; ++mt)
#pragma unroll
        for (int nt = 0; nt < 2; ++nt)
#pragma unroll
            for (int r = 0; r < 16; ++r) { const float c_ = ac[mt][nt][r], s_ = as[mt][nt][r]; ac[mt][nt][r] = c_ + s_; as[mt][nt][r] = c_ - s_; }
#pragma unroll
    for (int mt = 0; mt < 2; ++mt) { const int srow = mt_ * 256 + wm * 64 + mt * 32 + l31;
#pragma unroll
        for (int nt = 0; nt < 2; ++nt)
#pragma unroll
            for (int gp = 0; gp < 2; ++gp) { const int c = nt_ * 128 + wn * 64 + nt * 32 + gp * 16; const int g0 = 2 * gp, g1 = 2 * gp + 1;
                u32x2 oa, ob, ma, mb;
                oa.x = pk2(ac[mt][nt][4 * g0], ac[mt][nt][4 * g0 + 1]); oa.y = pk2(ac[mt][nt][4 * g0 + 2], ac[mt][nt][4 * g0 + 3]);
                ob.x = pk2(ac[mt][nt][4 * g1], ac[mt][nt][4 * g1 + 1]); ob.y = pk2(ac[mt][nt][4 * g1 + 2], ac[mt][nt][4 * g1 + 3]);
                ma.x = pk2(as[mt][nt][4 * g0], as[mt][nt][4 * g0 + 1]); ma.y = pk2(as[mt][nt][4 * g0 + 2], as[mt][nt][4 * g0 + 3]);
                mb.x = pk2(as[mt][nt][4 * g1], as[mt][nt][4 * g1 + 1]); mb.y = pk2(as[mt][nt][4 * g1 + 2], as[mt][nt][4 * g1 + 3]);
                st_pair16(yf + (size_t)(tb0 + srow) * 512 + c, oa, ob, lh);
                st_pair16_if(yf + (size_t)(tb0 + 4096 - srow) * 512 + c, ma, mb, lh, srow > 0); } }
    if (mt_ == 0) {
        const int col = tid >> 2, q = tid & 3; const bf16_t* zr = Z + (size_t)col * 8192 + q * 1024; float sacc = 0.f;
#pragma unroll 4
        for (int i = 0; i < 128; ++i) { const u32x4 v = gld16(zr + i * 8); const unsigned vw[4] = {v.x, v.y, v.z, v.w};
#pragma unroll
            for (int e = 0; e < 4; ++e) sacc += bf2f(vw[e] & 0xffffu) - bf2f(vw[e] >> 16); }
        sacc += __shfl_xor(sacc, 1); sacc += __shfl_xor(sacc, 2);
        if (q == 0) yf[(size_t)(tb0 + 2048) * 512 + nt_ * 128 + col] = (bf16_t)bfbits(sacc * (1.f / 64.f));
    }
}

constexpr int A_KP = 272, A_VP = 136, A_KSZ = 64 * A_KP, A_VSZ = 128 * A_VP, A_STAGE = A_KSZ + A_VSZ;
DI void attn_tile(const Params& p, int l, bool ctx, int b, int h, int qb, unsigned char* lds) {
    const int tid = get_tid(), lane = tid & 63, w = tid >> 6, mp = w & 1, rq = w >> 1, lh = lane >> 5, l31 = lane & 31;
    unsigned char* ws = p.ws;
    const int Tk = ctx ? 256 : KL; const int tb0 = ctx ? b * 256 : NCTXTOK + b * 4096;
    const int tok0 = tb0 + qb * 128;
    const bf16_t* Kp = (ctx ? (const bf16_t*)(ws + O_KDC) + (size_t)b * 256 * 512 : (const bf16_t*)(ws + O_KDL) + (size_t)b * KL * 512) + h * 128;
    const bf16_t* Vp = ctx ? (const bf16_t*)(ws + O_VTC) + ((size_t)b * 512 + h * 128) * 256 : (const bf16_t*)(ws + O_VTL) + ((size_t)b * 512 + h * 128) * KL;
    bf16_t* QD = (bf16_t*)(ws + O_QD);
    bf16x8 qf[4];
    { const bf16_t* qp = QD + (size_t)(tok0 + rq * 32 + l31) * 512 + h * 128 + mp * 64 + lh * 8;
#pragma unroll
        for (int ks = 0; ks < 4; ++ks) qf[ks] = *(const bf16x8*)(qp + ks * 16); }
    f32x16 O[4];
#pragma unroll
    for (int v = 0; v < 4; ++v)
#pragma unroll
        for (int r = 0; r < 16; ++r) O[v][r] = 0.f;
    float m_run = -1e30f, l_run = 0.f;
    const int nkt = Tk >> 6;
    u32x4 rk[2], rv[2];
    const int kr = tid >> 4, kc = (tid & 15) * 8;
    const int vr = tid >> 3, vc = (tid & 7) * 8;
    __syncthreads();
#pragma unroll
    for (int i = 0; i < 2; ++i) { rk[i] = gld16(Kp + (size_t)(kr + 32 * i) * 512 + kc); rv[i] = gld16(Vp + (size_t)(vr + 64 * i) * Tk + vc); }
#pragma unroll
    for (int i = 0; i < 2; ++i) { *(u32x4*)(lds + (kr + 32 * i) * A_KP + kc * 2) = rk[i]; { u32x2 lo_, hi_; lo_.x = rv[i].x; lo_.y = rv[i].y; hi_.x = rv[i].z; hi_.y = rv[i].w; *(u32x2*)(lds + A_KSZ + (vr + 64 * i) * A_VP + vc * 2) = lo_; *(u32x2*)(lds + A_KSZ + (vr + 64 * i) * A_VP + vc * 2 + 8) = hi_; } }
    if (nkt > 1) {
#pragma unroll
        for (int i = 0; i < 2; ++i) { rk[i] = gld16(Kp + (size_t)(64 + kr + 32 * i) * 512 + kc); rv[i] = gld16(Vp + (size_t)(vr + 64 * i) * Tk + 64 + vc); } }
    LBAR();
    for (int kt = 0; kt < nkt; ++kt) {
        unsigned char* cur = lds + (kt & 1) * A_STAGE; unsigned char* nxt = lds + ((kt + 1) & 1) * A_STAGE;
        if (kt + 1 < nkt) {
#pragma unroll
            for (int i = 0; i < 2; ++i) { *(u32x4*)(nxt + (kr + 32 * i) * A_KP + kc * 2) = rk[i]; { u32x2 lo_, hi_; lo_.x = rv[i].x; lo_.y = rv[i].y; hi_.x = rv[i].z; hi_.y = rv[i].w; *(u32x2*)(nxt + A_KSZ + (vr + 64 * i) * A_VP + vc * 2) = lo_; *(u32x2*)(nxt + A_KSZ + (vr + 64 * i) * A_VP + vc * 2 + 8) = hi_; } } }
        if (kt + 2 < nkt) { const int key0 = (kt + 2) * 64;
#pragma unroll
            for (int i = 0; i < 2; ++i) { rk[i] = gld16(Kp + (size_t)(key0 + kr + 32 * i) * 512 + kc); rv[i] = gld16(Vp + (size_t)(vr + 64 * i) * Tk + key0 + vc); } }
        __builtin_amdgcn_sched_barrier(0);
        f32x16 S[2];
#pragma unroll
        for (int s = 0; s < 2; ++s)
#pragma unroll
            for (int r = 0; r < 16; ++r) S[s][r] = 0.f;
        {
            bf16x8 kf[4][2];
#pragma unroll
            for (int ks = 0; ks < 4; ++ks)
#pragma unroll
                for (int sub = 0; sub < 2; ++sub) kf[ks][sub] = *(const bf16x8*)(cur + (sub * 32 + l31) * A_KP + (mp * 64 + ks * 16 + lh * 8) * 2);
#pragma unroll
            for (int ks = 0; ks < 4; ++ks)
#pragma unroll
                for (int sub = 0; sub < 2; ++sub) S[sub] = MFMA32(kf[ks][sub], qf[ks], S[sub]);
        }
        u32x2 vlo[2][4], vhi[2][4];
        const unsigned char* vbase = cur + A_KSZ + l31 * A_VP + 8 * lh;
#pragma unroll
        for (int v = 0; v < 4; ++v) { vlo[0][v] = *(const u32x2*)(vbase + v * 32 * A_VP); vhi[0][v] = *(const u32x2*)(vbase + v * 32 * A_VP + 16); }
        float mx = S[0][0];
#pragma unroll
        for (int sub = 0; sub < 2; ++sub)
#pragma unroll
            for (int r = 0; r < 16; ++r) mx = fmaxf(mx, S[sub][r]);
        mx = fmaxf(mx, __shfl_xor(mx, 32));
        float alpha = 1.f;
        if (!__all(mx - m_run <= 8.f)) {
            const float mn = fmaxf(m_run, mx); alpha = __builtin_amdgcn_exp2f(m_run - mn); m_run = mn;
#pragma unroll
            for (int v = 0; v < 4; ++v)
#pragma unroll
                for (int r = 0; r < 16; ++r) O[v][r] *= alpha;
        }
        const float mnew = m_run;
        float ps = 0.f;
#pragma unroll
        for (int g = 0; g < 4; ++g) {
            const int sub = g >> 1, s = g & 1;
            if (g < 3) {
                const int g1 = g + 1;
#pragma unroll
                for (int v = 0; v < 4; ++v) { vlo[g1 & 1][v] = *(const u32x2*)(vbase + v * 32 * A_VP + g1 * 32); vhi[g1 & 1][v] = *(const u32x2*)(vbase + v * 32 * A_VP + g1 * 32 + 16); }
            }
#pragma unroll
            for (int r = 0; r < 8; ++r) { const float e = __builtin_amdgcn_exp2f(S[sub][8 * s + r] - mnew); S[sub][8 * s + r] = e; ps += e; }
            u32x4 pw; pw.x = pk2(S[sub][8 * s], S[sub][8 * s + 1]); pw.y = pk2(S[sub][8 * s + 2], S[sub][8 * s + 3]);
            pw.z = pk2(S[sub][8 * s + 4], S[sub][8 * s + 5]); pw.w = pk2(S[sub][8 * s + 6], S[sub][8 * s + 7]);
            const bf16x8 pf = __builtin_bit_cast(bf16x8, pw);
#pragma unroll
            for (int v = 0; v < 4; ++v) {
                u32x4 vw; vw.x = vlo[g & 1][v].x; vw.y = vlo[g & 1][v].y; vw.z = vhi[g & 1][v].x; vw.w = vhi[g & 1][v].y;
                O[v] = MFMA32(__builtin_bit_cast(bf16x8, vw), pf, O[v]);
            }
        }
        l_run = l_run * alpha + ps;
        LBAR();
    }
    const float lt = l_run + __shfl_xor(l_run, 32); const float inv = 1.f / lt;
    float* os = (float*)lds;
    if (mp == 1) {
#pragma unroll
        for (int v = 0; v < 4; ++v)
#pragma unroll
            for (int r = 0; r < 16; ++r) os[((rq * 64 + v * 16 + r) << 6) + lane] = O[v][r] * inv;
    }
    __syncthreads();
    if (mp == 0) {
        const float lam = ((const float*)(ws + O_LAM))[l];
        float ss = 0.f;
#pragma unroll
        for (int v = 0; v < 4; ++v)
#pragma unroll
            for (int r = 0; r < 16; ++r) { const float o = O[v][r] * inv - lam * os[((rq * 64 + v * 16 + r) << 6) + lane]; O[v][r] = o; ss += o * o; }
        ss += __shfl_xor(ss, 32);
        const float rstd = rsqrtf(ss * (1.f / 128.f) + 1e-6f) * (1.f - lam_init_f(l));
        const float* gn = p.in[17] + l * 128;
        bf16_t* od = QD + (size_t)(tok0 + rq * 32 + l31) * 512 + h * 128;
#pragma unroll
        for (int v = 0; v < 4; ++v)
#pragma unroll
            for (int gp = 0; gp < 2; ++gp) { u32x2 ob[2];
#pragma unroll
                for (int h2 = 0; h2 < 2; ++h2) { const int g = 2 * gp + h2; const int c = v * 32 + g * 8 + lh * 4; const float4 gg = *(const float4*)(gn + c);
                    ob[h2].x = pk2(O[v][4 * g] * rstd * gg.x, O[v][4 * g + 1] * rstd * gg.y); ob[h2].y = pk2(O[v][4 * g + 2] * rstd * gg.z, O[v][4 * g + 3] * rstd * gg.w); }
                st_pair16(od + v * 32 + gp * 16, ob[0], ob[1], lh); }
    }
    __syncthreads();
}

constexpr int GP = 144;
constexpr int GL_QT = 0, GL_KT = 64 * GP, GL_KDT = 2 * 64 * GP, GL_ATT = 3 * 64 * GP, GL_VT = 4 * 64 * GP, GL_CUM = GL_VT + 128 * GP, GL_DIR = GL_CUM + 64 * 65 * 4;
constexpr int GL_W2 = GL_DIR;
static_assert(GL_W2 + 4352 <= LDS_BYTES - 64, "gla lds");
DI void gla_chain(const Params& p, int l, bool ctx, int b, int h, int dir, unsigned char* lds) {
    const int tid = get_tid(), lane = tid & 63, w = tid >> 6, vs = w & 3, ih = w >> 2, lh = lane >> 5, l31 = lane & 31;
    unsigned char* ws = p.ws;
    const int T = ctx ? TC : TL; const int tb0 = ctx ? b * 256 : NCTXTOK + b * 4096; const int nch = T >> 6;
    const bf16_t* QG = (const bf16_t*)(ws + O_QG); const bf16_t* KG = (const bf16_t*)(ws + O_KG);
    const bf16_t* VGT = (const bf16_t*)(ws + O_VGT) + (size_t)tb0 * 512 + (size_t)h * 128 * T;
    const float* AG = (const float*)(ws + O_AG);
    bf16_t* OGd = dir ? (bf16_t*)(ws + O_OGB) : (bf16_t*)(ws + O_HB) + (size_t)NTOK * 512;
    const float* w2 = p.in[12] + ((size_t)(l * 2 + dir) * 16) * 256 + h * 64;
    const float* ba = p.in[13] + (l * 2 + dir) * 256 + h * 64;
    float* cum = (float*)(lds + GL_CUM);
    float* agl = (float*)lds;
    float* w2l = (float*)(lds + GL_W2);
    f32x16 S[2];
    if (ctx) {
#pragma unroll
        for (int k2 = 0; k2 < 2; ++k2)
#pragma unroll
            for (int r = 0; r < 16; ++r) S[k2][r] = 0.f;
    } else {
        const float* s0 = p.in[5] + ((((size_t)b * DEPTH + l) * 2 + dir) * 4 + h) * 64 * 128;
#pragma unroll
        for (int k2 = 0; k2 < 2; ++k2)
#pragma unroll
            for (int r = 0; r < 16; ++r) S[k2][r] = s0[(size_t)(k2 * 32 + (r >> 2) * 8 + lh * 4 + (r & 3)) * 128 + vs * 32 + l31];
    }
    __syncthreads();
    for (int e = tid; e < 16 * 64; e += NTH) w2l[e] = w2[(e >> 6) * 256 + (e & 63)];
    if (tid < 64) w2l[1024 + tid] = ba[tid];
    const int jr = tid >> 3, kseg = (tid & 7) * 8;
    const int vrow = tid >> 2, vseg = (tid & 3) * 16;
    const int jlast = dir ? 0 : 63;
    u32x4 nq, nk, nvv[2]; f32v2 na2;
    { const int c0 = dir ? nch - 1 : 0; const int tk = tb0 + c0 * 64;
      nq = gld16(QG + (size_t)(tk + jr) * 256 + h * 64 + kseg); nk = gld16(KG + (size_t)(tk + jr) * 256 + h * 64 + kseg);
      const bf16_t* vp = VGT + (size_t)vrow * T + c0 * 64 + vseg; nvv[0] = gld16(vp); nvv[1] = gld16(vp + 8);
      na2 = *(const GAS f32v2*)(AG + (size_t)(tk + jr) * 32 + dir * 16 + (tid & 7) * 2); }
#pragma unroll 1
    for (int s = 0; s < nch; ++s) {
        const int c = dir ? nch - 1 - s : s; const int t0 = c * 64; const int tokc = tb0 + t0;
        LBAR();
        const u32x4 q0 = nq, k0 = nk;
        *(f32v2*)(agl + jr * 16 + (tid & 7) * 2) = na2;
        *(u32x4*)(lds + GL_VT + vrow * GP + vseg * 2) = nvv[0]; *(u32x4*)(lds + GL_VT + vrow * GP + vseg * 2 + 16) = nvv[1];
        if (s + 1 < nch) { const int c1 = dir ? c - 1 : c + 1; const int tk = tb0 + c1 * 64;
            nq = gld16(QG + (size_t)(tk + jr) * 256 + h * 64 + kseg); nk = gld16(KG + (size_t)(tk + jr) * 256 + h * 64 + kseg);
            const bf16_t* vp = VGT + (size_t)vrow * T + c1 * 64 + vseg; nvv[0] = gld16(vp); nvv[1] = gld16(vp + 8);
            na2 = *(const GAS f32v2*)(AG + (size_t)(tk + jr) * 32 + dir * 16 + (tid & 7) * 2); }
        LBAR();
        { const int k = tid & 63, jg = tid >> 6; float wc[16];
#pragma unroll
          for (int r = 0; r < 16; ++r) wc[r] = w2l[r * 64 + k];
          const float bk = w2l[1024 + k];
#pragma unroll 1
          for (int jj = 0; jj < 8; ++jj) { const int j = jg * 8 + jj; float z = bk;
#pragma unroll
              for (int r = 0; r < 16; ++r) z += agl[j * 16 + r] * wc[r];
              const float ls = fminf(z, 0.f) - __logf(1.f + __expf(-fabsf(z)));
              cum[j * 65 + k] = ls * (1.f / 16.f); } }
        LBAR();
        if (tid < 64) { float a = 0.f;
            if (dir == 0) {
#pragma unroll 8
                for (int j = 0; j < 64; ++j) { a += cum[j * 65 + tid]; cum[j * 65 + tid] = a; } }
            else {
#pragma unroll 8
                for (int j = 63; j >= 0; --j) { a += cum[j * 65 + tid]; cum[j * 65 + tid] = a; } } }
        LBAR();
        { const unsigned qa[4] = {q0.x, q0.y, q0.z, q0.w}, ka[4] = {k0.x, k0.y, k0.z, k0.w};
          unsigned qo[4], ko[4];
#pragma unroll
          for (int e = 0; e < 4; ++e) {
              const int kk = kseg + 2 * e;
              const float c0 = cum[jr * 65 + kk], c1 = cum[jr * 65 + kk + 1], l0 = cum[jlast * 65 + kk], l1 = cum[jlast * 65 + kk + 1];
              const float qa0 = bf2f(qa[e] & 0xffffu), qa1 = bf2f(qa[e] >> 16), ka0 = bf2f(ka[e] & 0xffffu), ka1 = bf2f(ka[e] >> 16);
              qo[e] = pk2(qa0 * __expf(c0), qa1 * __expf(c1));
              ko[e] = pk2(ka0 * __expf(-c0), ka1 * __expf(-c1));
              *(bf16_t*)(lds + GL_KDT + kk * GP + jr * 2) = (bf16_t)bfbits(ka0 * __expf(l0 - c0));
              *(bf16_t*)(lds + GL_KDT + (kk + 1) * GP + jr * 2) = (bf16_t)bfbits(ka1 * __expf(l1 - c1));
          }
          u32x4 t; t.x = qo[0]; t.y = qo[1]; t.z = qo[2]; t.w = qo[3]; *(u32x4*)(lds + GL_QT + jr * GP + kseg * 2) = t;
          t.x = ko[0]; t.y = ko[1]; t.z = ko[2]; t.w = ko[3]; *(u32x4*)(lds + GL_KT + jr * GP + kseg * 2) = t; }
        LBAR();
        if (w < 4) { const int it = w >> 1, jt = w & 1; f32x16 at;
#pragma unroll
          for (int r = 0; r < 16; ++r) at[r] = 0.f;
#pragma unroll
          for (int ks = 0; ks < 4; ++ks) {
              const bf16x8 kf = *(const bf16x8*)(lds + GL_KT + (jt * 32 + l31) * GP + (ks * 16 + lh * 8) * 2);
              const bf16x8 qf = *(const bf16x8*)(lds + GL_QT + (it * 32 + l31) * GP + (ks * 16 + lh * 8) * 2);
              at = MFMA32(kf, qf, at); }
          const int i = it * 32 + l31;
#pragma unroll
          for (int g = 0; g < 4; ++g) { float v4[4];
#pragma unroll
              for (int e = 0; e < 4; ++e) { const int j = jt * 32 + g * 8 + lh * 4 + e; const bool keep = dir ? (j >= i) : (j <= i); v4[e] = keep ? at[4 * g + e] : 0.f; }
              u32x2 o; o.x = pk2(v4[0], v4[1]); o.y = pk2(v4[2], v4[3]);
              *(u32x2*)(lds + GL_ATT + i * GP + (jt * 32 + g * 8 + lh * 4) * 2) = o; } }
        LBAR();
        f32x16 oa;
#pragma unroll
        for (int r = 0; r < 16; ++r) oa[r] = 0.f;
        bf16x8 vf[4];
#pragma unroll
        for (int js = 0; js < 4; ++js) vf[js] = *(const bf16x8*)(lds + GL_VT + (vs * 32 + l31) * GP + (js * 16 + lh * 8) * 2);
#pragma unroll
        for (int js = 0; js < 4; ++js) {
            const bf16x8 af = *(const bf16x8*)(lds + GL_ATT + (ih * 32 + l31) * GP + (js * 16 + lh * 8) * 2);
            oa = MFMA32(af, vf[js], oa); }
#pragma unroll
        for (int k2 = 0; k2 < 2; ++k2)
#pragma unroll
            for (int s2 = 0; s2 < 2; ++s2) {
                u32x4 sw; sw.x = pk2(S[k2][8 * s2], S[k2][8 * s2 + 1]); sw.y = pk2(S[k2][8 * s2 + 2], S[k2][8 * s2 + 3]);
                sw.z = pk2(S[k2][8 * s2 + 4], S[k2][8 * s2 + 5]); sw.w = pk2(S[k2][8 * s2 + 6], S[k2][8 * s2 + 7]);
                const unsigned char* qp = lds + GL_QT + (ih * 32 + l31) * GP + (k2 * 32 + 16 * s2 + 4 * lh) * 2;
                const u32x2 lo = *(const u32x2*)qp, hi = *(const u32x2*)(qp + 16);
                u32x4 qw; qw.x = lo.x; qw.y = lo.y; qw.z = hi.x; qw.w = hi.y;
                oa = MFMA32(__builtin_bit_cast(bf16x8, qw), __builtin_bit_cast(bf16x8, sw), oa);
            }
#pragma unroll
        for (int k2 = 0; k2 < 2; ++k2) {
#pragma unroll
            for (int r = 0; r < 16; ++r) S[k2][r] *= __expf(cum[jlast * 65 + k2 * 32 + (r >> 2) * 8 + lh * 4 + (r & 3)]);
#pragma unroll
            for (int js = 0; js < 4; ++js) {
                const bf16x8 kf = *(const bf16x8*)(lds + GL_KDT + (k2 * 32 + l31) * GP + (js * 16 + lh * 8) * 2);
                S[k2] = MFMA32(kf, vf[js], S[k2]); }
        }
        { bf16_t* op = OGd + (size_t)(tokc + ih * 32 + lh * 4) * 512 + h * 128 + vs * 32 + l31;
#pragma unroll
          for (int r = 0; r < 16; ++r) ((GAS bf16_t*)op)[(size_t)((r >> 2) * 8 + (r & 3)) * 512] = (bf16_t)bfbits(oa[r]); }
    }
    if (ctx && ih == 0) {
        float* so = p.out + OUT_ST + ((((size_t)b * DEPTH + l) * 2 + dir) * 4 + h) * 64 * 128;
#pragma unroll
        for (int k2 = 0; k2 < 2; ++k2)
#pragma unroll
            for (int r = 0; r < 16; ++r) so[(size_t)(k2 * 32 + (r >> 2) * 8 + lh * 4 + (r & 3)) * 128 + vs * 32 + l31] = S[k2][r];
    }
    __syncthreads();
}

DI void gla_combine(const Params& p, int l) {
    const int lane = get_tid() & 63, gw = get_bid() * 8 + (get_tid() >> 6), ngw = get_nblk() * 8;
    bf16_t* OGF = (bf16_t*)(p.ws + O_HB) + (size_t)NTOK * 512; const bf16_t* OGB = (const bf16_t*)(p.ws + O_OGB); const bf16_t* RG = (const bf16_t*)(p.ws + O_RG);
    const float* gn = p.in[14] + l * 128 + (lane & 15) * 8;
    const float4 g0 = *(const float4*)gn, g1 = *(const float4*)(gn + 4);
    const float gg[8] = {g0.x, g0.y, g0.z, g0.w, g1.x, g1.y, g1.z, g1.w};
    u32x4 na, nb, nr;
    if (gw < NTOK) { const size_t o = (size_t)gw * 512 + lane * 8; na = gld16(OGF + o); nb = gld16(OGB + o); nr = gld16(RG + o); }
    for (int tok = gw; tok < NTOK; tok += ngw) {
        const size_t o = (size_t)tok * 512 + lane * 8;
        const u32x4 a = na, bq = nb, rr = nr;
        if (tok + ngw < NTOK) { const size_t o2 = (size_t)(tok + ngw) * 512 + lane * 8; na = gld16(OGF + o2); nb = gld16(OGB + o2); nr = gld16(RG + o2); }
        const unsigned aw[4] = {a.x, a.y, a.z, a.w}, bw[4] = {bq.x, bq.y, bq.z, bq.w}, rw[4] = {rr.x, rr.y, rr.z, rr.w};
        float v[8]; float ss = 0.f;
#pragma unroll
        for (int q = 0; q < 4; ++q) { v[2 * q] = bf2f(aw[q] & 0xffffu) + bf2f(bw[q] & 0xffffu); v[2 * q + 1] = bf2f(aw[q] >> 16) + bf2f(bw[q] >> 16); ss += v[2 * q] * v[2 * q] + v[2 * q + 1] * v[2 * q + 1]; }
        ss += __shfl_xor(ss, 1); ss += __shfl_xor(ss, 2); ss += __shfl_xor(ss, 4); ss += __shfl_xor(ss, 8);
        const float rstd = rsqrtf(ss * (1.f / 128.f) + 1e-6f);
        unsigned ow[4];
#pragma unroll
        for (int q = 0; q < 4; ++q) ow[q] = pk2(v[2 * q] * rstd * gg[2 * q] * siluf_(bf2f(rw[q] & 0xffffu)), v[2 * q + 1] * rstd * gg[2 * q + 1] * siluf_(bf2f(rw[q] >> 16)));
        u32x4 t; t.x = ow[0]; t.y = ow[1]; t.z = ow[2]; t.w = ow[3];
        *(u32x4*)(OGF + o) = t;
    }
}

DI unsigned xcc_id() { return (unsigned)__builtin_amdgcn_s_getreg((3 << 11) | 20) & 7u; }
DI int mtile_of(int x, int i) { return i < 2 ? 2 * x + i : 16 + 16 * x + (i - 2); }
template <class F>
DI void xcd_queue(const Params& p, int l, int slot, int per_xcd, unsigned char* lds, F f) {
    int* s_item = (int*)(lds + LDS_BYTES - 16);
    unsigned* cnt = (unsigned*)(p.ws + O_CNT) + (l * 6 + slot) * 8;
    const int x0 = (int)xcc_id();
    for (int dx = 0; dx < 8; ++dx) {
        const int x = (x0 + dx) & 7;
        for (;;) {
            __syncthreads();
            if (get_tid() == 0) *s_item = (int)atomicAdd(cnt + x, 1u);
            __syncthreads();
            const int j = *s_item;
            if (j >= per_xcd) break;
            f(x, j);
        }
    }
}
constexpr int MX_GL = 8, MX_GC = 16, MX_AL = 128, MX_FL = 32, MX_AC = 16, MX_FC = 8, MX_N = MX_GL + MX_GC + MX_AL + MX_FL + MX_AC + MX_FC;
template <int MIXSEL>
DI void phase_mix(const Params& p, int l, unsigned char* lds) {
    xcd_queue(p, l, 1, MX_N, lds, [&](int x, int it) {
        if (it < MX_GL) { if (MIXSEL & 1) gla_chain(p, l, false, x, it >> 1, it & 1, lds); return; } it -= MX_GL;
        if (it < MX_FL) { if (MIXSEL & 4) dft_lat_tile(p, x, it >> 2, it & 3, lds); return; } it -= MX_FL;
        if (it < MX_GC) { const int g = x * 16 + it; if (MIXSEL & 1) gla_chain(p, l, true, g >> 3, (g >> 1) & 3, g & 1, lds); return; } it -= MX_GC;
        if (it < MX_AL) { if (MIXSEL & 2) attn_tile(p, l, false, x, it >> 5, it & 31, lds); return; } it -= MX_AL;
        if (it < MX_AC) { const int g = x * 16 + it; if (MIXSEL & 2) attn_tile(p, l, true, g >> 3, (g >> 1) & 3, g & 1, lds); return; } it -= MX_AC;
        { const int g = x * 8 + it; if (MIXSEL & 4) dft_tile(p, true, g >> 2, 0, g & 3, lds); }
    });
}

DI void mrg_tile(const Params& p, int l, int mtile, int ntile, unsigned char* lds) {
    const int tid = get_tid(), lane = tid & 63, w = tid >> 6, wm = w >> 1, wn = w & 1, lh = lane >> 5, l31 = lane & 31;
    unsigned char* ws = p.ws;
    const int m0 = mtile * 256, n0 = ntile * 128;
    unsigned totpk[2][2][8];
    ALoadBF alh{(const bf16_t*)(ws + O_ZT) + (size_t)m0 * 1024, 1024};
#pragma unroll 1
    for (int br = 0; br < 3; ++br) {
        unsigned gpk[2][2][8];
        {
            f32x16 g[2][2]; acc_zero<2>(g);
            gemm_kloop<2>(g, alh, (const bf16_t*)(ws + O_WGT) + (size_t)(br * 1024 + n0) * 1024, 1024, 1024, lds);
#pragma unroll
            for (int a = 0; a < 2; ++a)
#pragma unroll
                for (int b = 0; b < 2; ++b)
#pragma unroll
                    for (int r = 0; r < 8; ++r) gpk[a][b][r] = pk2(sigmoidf_(g[a][b][2 * r]), sigmoidf_(g[a][b][2 * r + 1]));
        }
        f32x16 y[2][2]; acc_zero<2>(y);
        const bf16_t* Ab = br == 0 ? (const bf16_t*)(ws + O_HB) : (br == 1 ? (const bf16_t*)(ws + O_HB) + (size_t)NTOK * 512 : (const bf16_t*)(ws + O_QD));
        const bf16_t* Wb = (const bf16_t*)(ws + (br == 0 ? O_WFOU : (br == 1 ? O_WGO : O_WDO)));
        ALoadBF al{Ab + (size_t)m0 * 512, 512};
        gemm_kloop<2>(y, al, Wb + (size_t)n0 * 512, 512, 512, lds);
#pragma unroll
        for (int a = 0; a < 2; ++a)
#pragma unroll
            for (int b = 0; b < 2; ++b)
#pragma unroll
                for (int r = 0; r < 8; ++r) {
                    float t0 = bf2f(gpk[a][b][r] & 0xffffu) * y[a][b][2 * r], t1 = bf2f(gpk[a][b][r] >> 16) * y[a][b][2 * r + 1];
                    if (br > 0) { t0 += bf2f(totpk[a][b][r] & 0xffffu); t1 += bf2f(totpk[a][b][r] >> 16); }
                    totpk[a][b][r] = pk2(t0, t1);
                }
    }
    bf16_t* mg = (bf16_t*)(ws + O_MG);
#pragma unroll
    for (int mt = 0; mt < 2; ++mt) { const int row = m0 + wm * 64 + mt * 32 + l31;
#pragma unroll
        for (int nt = 0; nt < 2; ++nt)
#pragma unroll
            for (int gp = 0; gp < 2; ++gp) { u32x2 oa, ob; oa.x = totpk[mt][nt][4 * gp]; oa.y = totpk[mt][nt][4 * gp + 1]; ob.x = totpk[mt][nt][4 * gp + 2]; ob.y = totpk[mt][nt][4 * gp + 3];
                st_pair16(mg + (size_t)row * 1024 + n0 + wn * 64 + nt * 32 + gp * 16, oa, ob, lh); } }
}

DI void res_tile(const Params& p, int l, int mtile, int ntile, const bf16_t* A, int lda, const bf16_t* Bt, int K, int gofs, bool first, unsigned char* lds) {
    const int tid = get_tid(), lane = tid & 63, w = tid >> 6, wm = w >> 1, wn = w & 1, lh = lane >> 5, l31 = lane & 31;
    const int m0 = mtile * 256, n0 = ntile * 128;
    f32x16 acc[2][2]; acc_zero<2>(acc);
    ALoadBF al{A + (size_t)m0 * lda, lda};
    gemm_kloop<2>(acc, al, Bt + (size_t)n0 * K, K, K, lds);
    const float* gv = (const float*)(p.ws + O_MOD) + ((size_t)l * 9 + tok_r(m0)) * 6144 + gofs;
#pragma unroll
    for (int mt = 0; mt < 2; ++mt) { const int row = m0 + wm * 64 + mt * 32 + l31;
        const float* xi = first ? xrow_ptr(p, l, row) : p.out + (size_t)row * 1024;
        float* xo = p.out + (size_t)row * 1024;
#pragma unroll
        for (int nt = 0; nt < 2; ++nt)
#pragma unroll
            for (int g = 0; g < 4; ++g) { const int c = n0 + wn * 64 + nt * 32 + g * 8 + lh * 4;
                const float4 xv = *(const float4*)(xi + c), gg = *(const float4*)(gv + c);
                *(float4*)(xo + c) = make_float4(xv.x + gg.x * acc[mt][nt][4 * g], xv.y + gg.y * acc[mt][nt][4 * g + 1], xv.z + gg.z * acc[mt][nt][4 * g + 2], xv.w + gg.w * acc[mt][nt][4 * g + 3]); } }
}

DI void ff1_tile(const Params& p, int mtile, int ntile, unsigned char* lds) {
    const int tid = get_tid(), lane = tid & 63, w = tid >> 6, wm = w >> 1, wn = w & 1, lh = lane >> 5, l31 = lane & 31;
    unsigned char* ws = p.ws;
    const int m0 = mtile * 256;
    f32x16 acc[2][4]; acc_zero<4>(acc);
    ALoadBF al{(const bf16_t*)(ws + O_HB) + (size_t)m0 * 1024, 1024};
    gemm_kloop<4>(acc, al, (const bf16_t*)(ws + O_WGU) + (size_t)ntile * 256 * 1024, 1024, 1024, lds);
    bf16_t* act = (bf16_t*)(ws + O_ACT);
#pragma unroll
    for (int mt = 0; mt < 2; ++mt) { const int row = m0 + wm * 64 + mt * 32 + l31;
#pragma unroll
        for (int pr = 0; pr < 2; ++pr)
#pragma unroll
        for (int gp = 0; gp < 2; ++gp) { u32x2 ob[2];
#pragma unroll
            for (int h2 = 0; h2 < 2; ++h2) { const int g = 2 * gp + h2; float v[4];
#pragma unroll
                for (int e = 0; e < 4; ++e) v[e] = siluf_(acc[mt][2 * pr][4 * g + e]) * acc[mt][2 * pr + 1][4 * g + e];
                ob[h2].x = pk2(v[0], v[1]); ob[h2].y = pk2(v[2], v[3]); }
            st_pair16(act + (size_t)row * DFF + (2 * ntile + wn) * 64 + pr * 32 + gp * 16, ob[0], ob[1], lh); } }
}

DI void grid_barrier(unsigned* bar, unsigned nblk) {
    __syncthreads();
    if (get_tid() == 0) {
        __builtin_amdgcn_fence(__ATOMIC_RELEASE, "agent");
        unsigned* gen = bar + 320;
        const unsigned g0 = __hip_atomic_load(gen, __ATOMIC_RELAXED, __HIP_MEMORY_SCOPE_AGENT);
        const unsigned grp = (unsigned)get_bid() & 7u;
        const unsigned per = nblk >> 3, extra = nblk & 7u;
        const unsigned want = per + (grp < extra ? 1u : 0u);
        bool released = false;
        if (__hip_atomic_fetch_add(bar + 32 * grp, 1u, __ATOMIC_RELAXED, __HIP_MEMORY_SCOPE_AGENT) == want - 1) {
            const unsigned ngrp = per ? 8u : extra;
            if (__hip_atomic_fetch_add(bar + 288, 1u, __ATOMIC_RELAXED, __HIP_MEMORY_SCOPE_AGENT) == ngrp - 1) {
#pragma unroll
                for (int i = 0; i < 8; ++i) __hip_atomic_store(bar + 32 * i, 0u, __ATOMIC_RELAXED, __HIP_MEMORY_SCOPE_AGENT);
                __hip_atomic_store(bar + 288, 0u, __ATOMIC_RELAXED, __HIP_MEMORY_SCOPE_AGENT);
                __hip_atomic_fetch_add(gen, 1u, __ATOMIC_RELEASE, __HIP_MEMORY_SCOPE_AGENT);
                released = true;
            }
        }
        if (!released) while (__hip_atomic_load(gen, __ATOMIC_RELAXED, __HIP_MEMORY_SCOPE_AGENT) == g0) __builtin_amdgcn_s_sleep(1);
        __builtin_amdgcn_fence(__ATOMIC_ACQUIRE, "agent");
    }
    __syncthreads();
}

#define EN(n) ((MASK >> (n)) & 1)
template <int MASK, int MIXSEL>
__global__ void __launch_bounds__(NTH) fwd_kernel(Params p) {
    extern __shared__ __attribute__((aligned(16))) unsigned char lds[];
    cg::grid_group grid = cg::this_grid();
    const Params& p0 = p;
    for (int ph = p0.ph_lo; ph < p0.ph_hi; ++ph) {
        if (ph == p0.ph_lo + 1) grid.sync();
        else if (ph > p0.ph_lo) grid_barrier((unsigned*)(p0.ws + O_BAR), (unsigned)get_nblk());
        Params p = p0;
        asm volatile("" : "+s"(p.ws)); asm volatile("" : "+s"(p.out));
        if (ph == 0) { if (EN(0)) phase_prep(p, lds); continue; }
        if (ph == 1) { if (EN(1)) phase_modreduce(p); continue; }
        const int l = (ph - 2) / 9, q = (ph - 2) % 9;
        unsigned char* ws = p.ws;
        switch (q) {
        case 0: if (!EN(2)) break;
            if (l > 0) { convert_weights(p, l, lds); convert_cache(p, l); }
            phase_norm(p, l, 0, O_HB);
            break;
        case 1: if (!EN(3)) break;
            xcd_queue(p, l, 0, 18 * 17, lds, [&](int x, int j) { const int g = j / 102, r = j % 102; g1_tile(p, l, mtile_of(x, 6 * g + r % 6), r / 6, lds); });
            break;
        case 2: if (!EN(4)) break;
            phase_mix<MIXSEL>(p, l, lds);
            break;
        case 3: if (!EN(2)) break;
            phase_norm(p, l, 0, O_ZT);
            gla_combine(p, l);
            break;
        case 4: if (!EN(5)) break;
            xcd_queue(p, l, 2, 18 * 8, lds, [&](int x, int j) { mrg_tile(p, l, mtile_of(x, j >> 3), j & 7, lds); });
            break;
        case 5: if (!EN(6)) break;
            xcd_queue(p, l, 3, 18 * 8, lds, [&](int x, int j) { res_tile(p, l, mtile_of(x, j >> 3), j & 7, (const bf16_t*)(ws + O_MG), 1024, (const bf16_t*)(ws + O_WOUT), 1024, 2048, true, lds); });
            break;
        case 6: if (!EN(7)) break;
            phase_norm(p, l, 1, O_HB);
            break;
        case 7: if (!EN(8)) break;
            xcd_queue(p, l, 4, 18 * 22, lds, [&](int x, int j) { const int g = j / 132, r = j % 132; ff1_tile(p, mtile_of(x, 6 * g + r % 6), r / 6, lds); });
            break;
        case 8: if (!EN(9)) break;
            xcd_queue(p, l, 5, 18 * 8, lds, [&](int x, int j) { res_tile(p, l, mtile_of(x, j >> 3), j & 7, (const bf16_t*)(ws + O_ACT), DFF, (const bf16_t*)(ws + O_WDN), DFF, 5120, false, lds); });
            break;
        }
    }
}

template <int MASK, int MIXSEL>
static void launch_ph(const Params& p0, int ph, int grid, hipStream_t stream) {
    static bool attr = false;
    if (!attr) { (void)hipFuncSetAttribute((const void*)fwd_kernel<MASK, MIXSEL>, hipFuncAttributeMaxDynamicSharedMemorySize, LDS_BYTES); attr = true; }
    Params p = p0; p.ph_lo = ph; p.ph_hi = ph + 1;
    hipLaunchKernelGGL((fwd_kernel<MASK, MIXSEL>), dim3(grid), dim3(NTH), LDS_BYTES, stream, p);
}

extern "C" void kernel_launch(void* const* d_in, const int* in_sizes, int n_in, void* d_out, int out_size, void* d_ws, size_t ws_size, hipStream_t stream) {
    static int grid_blocks = 0;
    if (grid_blocks == 0) {
        if (ws_size < WS_END) { fprintf(stderr, "workspace too small: %zu < %zu\n", ws_size, (size_t)WS_END); grid_blocks = -1; return; }
        int dev = 0, cus = 0;
        (void)hipGetDevice(&dev);
        (void)hipDeviceGetAttribute(&cus, hipDeviceAttributeMultiprocessorCount, dev);
        grid_blocks = cus > 0 ? cus : 256;
#if ONE_LAUNCH
        int per_cu = 0;
        if (hipFuncSetAttribute((const void*)fwd_kernel<0xffff, 7>, hipFuncAttributeMaxDynamicSharedMemorySize, LDS_BYTES) != hipSuccess) { fprintf(stderr, "hipFuncSetAttribute failed\n"); grid_blocks = -1; return; }
        (void)hipOccupancyMaxActiveBlocksPerMultiprocessor(&per_cu, (const void*)fwd_kernel<0xffff, 7>, NTH, LDS_BYTES);
        if (per_cu < 1) per_cu = 1;
        grid_blocks = cus * per_cu;
#endif
        (void)hipGetLastError();
    }
    if (grid_blocks < 0) return;
    (void)hipMemsetAsync((unsigned char*)d_ws + O_CNT, 0, 1024 + 2048, stream);
    Params p{};
    for (int i = 0; i < 25; ++i) p.in[i] = (const float*)d_in[i];
    p.out = (float*)d_out; p.ws = (unsigned char*)d_ws;
    constexpr int NPH = 2 + 9 * DEPTH;
#if ONE_LAUNCH
    p.ph_lo = 0; p.ph_hi = NPH;
    void* args[] = {&p};
    hipError_t e = hipLaunchCooperativeKernel((const void*)fwd_kernel<0xffff, 7>, dim3(grid_blocks), dim3(NTH), args, LDS_BYTES, stream);
    if (e != hipSuccess) fprintf(stderr, "cooperative launch failed: %s (grid %d)\n", hipGetErrorString(e), grid_blocks);
#else
    for (int ph = 0; ph < NPH; ++ph) {
        const int q = ph < 2 ? -1 : (ph - 2) % 9;
        if (q == -1 || q == 0 || q == 3 || q == 6) launch_ph<0x0087, 0>(p, ph, grid_blocks, stream);
        else if (q == 1) launch_ph<0x0008, 0>(p, ph, grid_blocks, stream);
        else if (q == 2) { launch_ph<0x0010, 1>(p, ph, grid_blocks, stream); launch_ph<0x0010, 6>(p, ph, grid_blocks, stream); }
        else if (q == 4) launch_ph<0x0020, 0>(p, ph, grid_blocks, stream);
        else launch_ph<0x0340, 0>(p, ph, grid_blocks, stream);
    }
#endif
}
```

```cpp
#include <hip/hip_runtime.h>
#include <hip/hip_cooperative_groups.h>
#include <cstdio>
#include <cmath>
namespace cg = cooperative_groups;

#ifndef ONE_LAUNCH
#define ONE_LAUNCH 1
#endif

typedef unsigned short bf16_t;
typedef short bf16x8 __attribute__((ext_vector_type(8)));
typedef float f32x16 __attribute__((ext_vector_type(16)));
typedef unsigned u32x4 __attribute__((ext_vector_type(4)));
typedef unsigned u32x2 __attribute__((ext_vector_type(2)));
#define DI __device__ __forceinline__
#define LBAR() asm volatile("s_waitcnt lgkmcnt(0)\n\ts_barrier" ::: "memory")
#define MFMA32(a, b, c) __builtin_amdgcn_mfma_f32_32x32x16_bf16((a), (b), (c), 0, 0, 0)

constexpr int DM = 1024, NTOK = 36864, NCTXTOK = 4096, TL = 4096, TC = 256, NB_C = 16, NB_L = 8, DEPTH = 4;
constexpr int INC = 6688, DFF = 2816, KL = 4352;
constexpr int NWIN = 4224;
constexpr int NTH = 512;
constexpr int LDS_BYTES = 153600;

constexpr size_t al256(size_t x) { return (x + 255) & ~(size_t)255; }
constexpr size_t O_WIN = 0;
constexpr size_t O_WGT = O_WIN + (size_t)NWIN * 1024 * 2;
constexpr size_t O_WFOU = O_WGT + (size_t)3072 * 1024 * 2;
constexpr size_t O_WGO = O_WFOU + (size_t)1024 * 512 * 2;
constexpr size_t O_WDO = O_WGO + (size_t)1024 * 512 * 2;
constexpr size_t O_WOUT = O_WDO + (size_t)1024 * 512 * 2;
constexpr size_t O_WGU = O_WOUT + (size_t)1024 * 1024 * 2;
constexpr size_t O_WDN = O_WGU + (size_t)5632 * 1024 * 2;
constexpr size_t O_DL = O_WDN + (size_t)1024 * 2816 * 2;
constexpr size_t O_DC = O_DL + (size_t)4096 * 8192 * 2;
constexpr size_t O_HB = O_DC + (size_t)256 * 512 * 2;
constexpr size_t O_ZT = O_HB + (size_t)NTOK * 1024 * 2;
constexpr size_t O_QG = O_ZT + (size_t)NTOK * 1024 * 2;
constexpr size_t O_KG = O_QG + (size_t)NTOK * 256 * 2;
constexpr size_t O_VGT = O_KG + (size_t)NTOK * 256 * 2;
constexpr size_t O_RG = O_VGT + (size_t)NTOK * 512 * 2;
constexpr size_t O_AG = O_RG + (size_t)NTOK * 512 * 2;
constexpr size_t O_QD = O_AG + (size_t)NTOK * 32 * 4;
constexpr size_t O_KDL = O_QD + (size_t)NTOK * 512 * 2;
constexpr size_t O_KDC = O_KDL + (size_t)NB_L * KL * 512 * 2;
constexpr size_t O_VTL = O_KDC + (size_t)NB_C * 256 * 512 * 2;
constexpr size_t O_VTC = O_VTL + (size_t)NB_L * 512 * KL * 2;
constexpr size_t O_MOD = O_VTC + (size_t)NB_C * 512 * 256 * 2;
constexpr size_t O_MODP = O_ZT;
constexpr size_t O_OGB = O_MOD + (size_t)DEPTH * 9 * 6144 * 4;
constexpr size_t O_ROPE = O_OGB + (size_t)NTOK * 512 * 2;
constexpr size_t O_LAM = O_ROPE + (size_t)64 * 16 * 8;
constexpr size_t O_CNT = O_LAM + 256;
constexpr size_t O_BAR = O_CNT + 1024;
constexpr size_t WS_END = O_BAR + 2048;
constexpr size_t O_ACT = O_ZT;
constexpr size_t O_MG = O_QG;
static_assert(O_ACT + (size_t)NTOK * DFF * 2 <= O_KDL, "ACT alias overflow");

constexpr size_t OUT_CK = (size_t)NTOK * 1024;
constexpr size_t OUT_CV = OUT_CK + (size_t)16 * 4 * 256 * 512;
constexpr size_t OUT_ST = OUT_CV + (size_t)16 * 4 * 256 * 512;

struct Params {
    const float* in[25];
    float* out;
    unsigned char* ws;
    int ph_lo, ph_hi;
};

DI int get_tid() { int t = threadIdx.x; asm volatile("" : "+v"(t)); return t; }
DI int get_nblk() { int b = gridDim.x; asm volatile("" : "+s"(b)); return b; }
DI int get_bid() { int b = blockIdx.x; asm volatile("" : "+s"(b)); return b; }
typedef __bf16 bf16v2 __attribute__((ext_vector_type(2)));
typedef float f32v2 __attribute__((ext_vector_type(2)));
DI unsigned pk2(float lo, float hi) { f32v2 v = {lo, hi}; return __builtin_bit_cast(unsigned, __builtin_convertvector(v, bf16v2)); }
DI unsigned bfbits(float x) { return pk2(x, 0.f) & 0xffffu; }
#define GAS __attribute__((address_space(1)))
DI u32x4 gld16(const void* p) { return *(const GAS u32x4*)p; }
DI void st_pair16_if(bf16_t* p, u32x2 a, u32x2 b, int lh, bool ok) {
    const auto r = __builtin_amdgcn_permlane32_swap(a.x, b.x, false, false);
    const auto q = __builtin_amdgcn_permlane32_swap(a.y, b.y, false, false);
    u32x4 v; v.x = r[0]; v.y = q[0]; v.z = r[1]; v.w = q[1];
    if (ok) *(u32x4*)(p + lh * 8) = v;
}
DI void st_pair16(bf16_t* p, u32x2 a, u32x2 b, int lh) {
    const auto r = __builtin_amdgcn_permlane32_swap(a.x, b.x, false, false);
    const auto q = __builtin_amdgcn_permlane32_swap(a.y, b.y, false, false);
    u32x4 v; v.x = r[0]; v.y = q[0]; v.z = r[1]; v.w = q[1];
    *(u32x4*)(p + lh * 8) = v;
}
DI float bf2f(unsigned b) { return __uint_as_float(b << 16); }
DI float wave_sum(float v) {
#pragma unroll
    for (int o = 1; o < 64; o <<= 1) v += __shfl_xor(v, o);
    return v;
}
DI float sigmoidf_(float x) { return 1.f / (1.f + __expf(-x)); }
DI float siluf_(float x) { return x / (1.f + __expf(-x)); }
DI float lam_init_f(int l) { return 0.8f - 0.6f * __expf(-0.3f * (float)l); }
DI int tok_r(int tok) { return tok < NCTXTOK ? 0 : 1 + ((tok - NCTXTOK) >> 12); }
DI int tok_batch0(int tok) { return tok < NCTXTOK ? (tok & ~255) : NCTXTOK + ((tok - NCTXTOK) & ~4095); }
DI const float* xrow_ptr(const Params& p, int layer, int tok) {
    const float* x0 = p.in[0]; const float* x1 = p.in[1]; const float* xo = p.out;
    const float* base = layer == 0 ? (tok < NCTXTOK ? x0 : x1) : xo;
    const size_t row = layer == 0 ? (size_t)(tok < NCTXTOK ? tok : tok - NCTXTOK) : (size_t)tok;
    return base + row * 1024;
}

constexpr int G_PITCH = 144;
constexpr int G_ASZ = 256 * G_PITCH, G_BSZ = 128 * G_PITCH, G_STAGE = G_ASZ + G_BSZ;

struct ALoadBF {
    const bf16_t* A; int lda;
    DI void load4(u32x4 (&ra)[4], int crow, int k) const {
#pragma unroll
        for (int i = 0; i < 4; ++i) ra[i] = gld16(A + (size_t)(crow + 64 * i) * lda + k);
    }
};
template <int NT, bool DB = true, class AL>
DI void gemm_kloop(f32x16 (&acc)[2][NT], const AL& al, const bf16_t* Bt, int ldb, int K, unsigned char* lds) {
    const int tid = get_tid(), lane = tid & 63, w = tid >> 6, wm = w >> 1, wn = w & 1;
    const int crow = tid >> 3, ck = (tid & 7) * 8;
    constexpr int STG = G_ASZ + 64 * NT * G_PITCH;
    u32x4 ra[4], rb[NT];
    int nk_ = K >> 6; asm volatile("" : "+s"(nk_));
    const int nk = nk_;
    __syncthreads();
    al.load4(ra, crow, ck);
#pragma unroll
    for (int i = 0; i < NT; ++i) rb[i] = gld16(Bt + (size_t)(crow + 64 * i) * ldb + ck);
#pragma unroll
    for (int i = 0; i < 4; ++i) *(u32x4*)(lds + (crow + 64 * i) * G_PITCH + ck * 2) = ra[i];
#pragma unroll
    for (int i = 0; i < NT; ++i) *(u32x4*)(lds + G_ASZ + (crow + 64 * i) * G_PITCH + ck * 2) = rb[i];
    if (nk > 1) {
        al.load4(ra, crow, 64 + ck);
#pragma unroll
        for (int i = 0; i < NT; ++i) rb[i] = gld16(Bt + (size_t)(crow + 64 * i) * ldb + 64 + ck);
    }
    LBAR();
    const int aoff = (wm * 64 + (lane & 31)) * G_PITCH + (lane >> 5) * 16;
    const int boff = G_ASZ + (wn * 32 * NT + (lane & 31)) * G_PITCH + (lane >> 5) * 16;
    for (int kt = 0; kt < nk; ++kt) {
        unsigned char* cur = lds + (kt & 1) * STG;
        unsigned char* nxt = lds + ((kt + 1) & 1) * STG;
        if constexpr (!DB) {
        if (kt + 1 < nk) {
#pragma unroll
            for (int i = 0; i < 4; ++i) *(u32x4*)(nxt + (crow + 64 * i) * G_PITCH + ck * 2) = ra[i];
#pragma unroll
            for (int i = 0; i < NT; ++i) *(u32x4*)(nxt + G_ASZ + (crow + 64 * i) * G_PITCH + ck * 2) = rb[i];
        }
        if (kt + 2 < nk) {
            const int k0 = (kt + 2) * 64 + ck;
            al.load4(ra, crow, k0);
#pragma unroll
            for (int i = 0; i < NT; ++i) rb[i] = gld16(Bt + (size_t)(crow + 64 * i) * ldb + k0);
        }
        __builtin_amdgcn_sched_barrier(0);
        }
        if constexpr (DB) {
        bf16x8 af[2][2], bfr[2][NT];
#pragma unroll
        for (int mt = 0; mt < 2; ++mt) af[0][mt] = *(const bf16x8*)(cur + aoff + mt * 32 * G_PITCH);
#pragma unroll
        for (int nt = 0; nt < NT; ++nt) bfr[0][nt] = *(const bf16x8*)(cur + boff + nt * 32 * G_PITCH);
#pragma unroll
        for (int ks = 0; ks < 4; ++ks) {
            if (ks < 3) {
#pragma unroll
                for (int mt = 0; mt < 2; ++mt) af[(ks + 1) & 1][mt] = *(const bf16x8*)(cur + aoff + mt * 32 * G_PITCH + (ks + 1) * 32);
#pragma unroll
                for (int nt = 0; nt < NT; ++nt) bfr[(ks + 1) & 1][nt] = *(const bf16x8*)(cur + boff + nt * 32 * G_PITCH + (ks + 1) * 32);
            }
            if (ks == 1) {
                __builtin_amdgcn_sched_barrier(0x10E);
                if (kt + 1 < nk) {
#pragma unroll
                    for (int i = 0; i < 4; ++i) *(u32x4*)(nxt + (crow + 64 * i) * G_PITCH + ck * 2) = ra[i];
#pragma unroll
                    for (int i = 0; i < NT; ++i) *(u32x4*)(nxt + G_ASZ + (crow + 64 * i) * G_PITCH + ck * 2) = rb[i];
                }
                if (kt + 2 < nk) {
                    const int k0 = (kt + 2) * 64 + ck;
                    al.load4(ra, crow, k0);
#pragma unroll
                    for (int i = 0; i < NT; ++i) rb[i] = gld16(Bt + (size_t)(crow + 64 * i) * ldb + k0);
                }
                __builtin_amdgcn_sched_barrier(0x10E);
            }
            __builtin_amdgcn_s_setprio(1);
#pragma unroll
            for (int mt = 0; mt < 2; ++mt)
#pragma unroll
                for (int nt = 0; nt < NT; ++nt) acc[mt][nt] = MFMA32(bfr[ks & 1][nt], af[ks & 1][mt], acc[mt][nt]);
            __builtin_amdgcn_s_setprio(0);
        }
        } else {
#pragma unroll
        for (int ks = 0; ks < 4; ++ks) {
            bf16x8 af[2], bfr[NT];
#pragma unroll
            for (int mt = 0; mt < 2; ++mt) af[mt] = *(const bf16x8*)(cur + aoff + mt * 32 * G_PITCH + ks * 32);
#pragma unroll
            for (int nt = 0; nt < NT; ++nt) bfr[nt] = *(const bf16x8*)(cur + boff + nt * 32 * G_PITCH + ks * 32);
#pragma unroll
            for (int mt = 0; mt < 2; ++mt)
#pragma unroll
                for (int nt = 0; nt < NT; ++nt) acc[mt][nt] = MFMA32(bfr[nt], af[mt], acc[mt][nt]);
            asm volatile("" ::: "memory");
        }
        }
        LBAR();
    }
}
template <int NT>
DI void acc_zero(f32x16 (&acc)[2][NT]) {
#pragma unroll
    for (int a = 0; a < 2; ++a)
#pragma unroll
        for (int b = 0; b < NT; ++b)
#pragma unroll
            for (int r = 0; r < 16; ++r) acc[a][b][r] = 0.f;
}

DI void transpose_item(const float* src, int ld, int K, int srccol, bf16_t* dst, int dstrow, int k0, float* scr, int lane, bool zero) {
#pragma unroll 8
    for (int i = 0; i < 32; ++i) { const int kk = 2 * i + (lane >> 5); scr[kk * 33 + (lane & 31)] = zero ? 0.f : src[(size_t)(k0 + kk) * ld + srccol + (lane & 31)]; }
    asm volatile("s_waitcnt lgkmcnt(0)" ::: "memory");
    const int c = lane & 7;
#pragma unroll
    for (int j = 0; j < 4; ++j) {
        const int n = (lane >> 3) + 8 * j; const float* s = scr + (8 * c) * 33 + n;
        u32x4 o; o.x = pk2(s[0], s[33]); o.y = pk2(s[66], s[99]); o.z = pk2(s[132], s[165]); o.w = pk2(s[198], s[231]);
        *(u32x4*)(dst + (size_t)(dstrow + n) * K + k0 + 8 * c) = o;
    }
    asm volatile("s_waitcnt lgkmcnt(0)" ::: "memory");
}

DI void convert_weights(const Params& p, int l, unsigned char* lds) {
    const int tid = get_tid(), lane = tid & 63, w = tid >> 6;
    float* scr = (float*)(lds + w * 8704);
    const int gw = get_bid() * 8 + w, ngw = get_nblk() * 8;
    __syncthreads();
    unsigned char* ws = p.ws;
    const float* w_in = p.in[11] + (size_t)l * 1024 * INC;
    const float* pw18 = p.in[18]; const float* pw19 = p.in[19]; const float* pw20 = p.in[20]; const float* pw22 = p.in[22]; const float* pw23 = p.in[23];
    constexpr int I_WIN = (NWIN - 1024) / 32 * 16;
    constexpr int I_WGT = 3072 / 32 * 16;
    constexpr int I_BR = 1024 / 32 * 8;
    constexpr int I_OUT = 1024 / 32 * 16;
    constexpr int I_GU = 5632 / 32 * 16;
    constexpr int I_DN = 1024 / 32 * 44;
    constexpr int NIT = I_WIN + I_WGT + 3 * I_BR + I_OUT + I_GU + I_DN;
    for (int it = gw; it < NIT; it += ngw) {
        int r = it;
        if (r < I_WIN) { const int rb = r / 16, kb = r % 16; const int prow = 1024 + rb * 32;
            const bool zero = (prow >= 2592 && prow < 2688); const int sc = prow < 2592 ? prow - 512 : prow - 608;
            transpose_item(w_in, INC, 1024, sc, (bf16_t*)(ws + O_WIN), prow, kb * 64, scr, lane, zero); continue; }
        r -= I_WIN;
        if (r < I_WGT) { const int rb = r / 16, kb = r % 16; transpose_item(w_in, INC, 1024, 3616 + rb * 32, (bf16_t*)(ws + O_WGT), rb * 32, kb * 64, scr, lane, false); continue; }
        r -= I_WGT;
        if (r < 3 * I_BR) { const int m = r / I_BR, q = r % I_BR, rb = q / 8, kb = q % 8;
            const float* src = (m == 0 ? pw18 : (m == 1 ? pw19 : pw20)) + (size_t)l * 512 * 1024;
            bf16_t* dst = (bf16_t*)(ws + (m == 0 ? O_WFOU : (m == 1 ? O_WGO : O_WDO)));
            transpose_item(src, 1024, 512, rb * 32, dst, rb * 32, kb * 64, scr, lane, false); continue; }
        r -= 3 * I_BR;
        if (r < I_OUT) { const int rb = r / 16, kb = r % 16; transpose_item(p.in[21] + (size_t)l * 1024 * 1024, 1024, 1024, rb * 32, (bf16_t*)(ws + O_WOUT), rb * 32, kb * 64, scr, lane, false); continue; }
        r -= I_OUT;
        if (r < I_GU) { const int rb = r / 16, kb = r % 16; const int prow = rb * 32; const int jt = prow >> 7, q = prow & 127, wn = q >> 6, nt = (q & 63) >> 5;
            const float* src = (nt ? pw23 : pw22) + (size_t)l * 1024 * DFF;
            transpose_item(src, DFF, 1024, jt * 64 + wn * 32, (bf16_t*)(ws + O_WGU), prow, kb * 64, scr, lane, false); continue; }
        r -= I_GU;
        { const int rb = r / 44, kb = r % 44; transpose_item(p.in[24] + (size_t)l * DFF * 1024, 1024, DFF, rb * 32, (bf16_t*)(ws + O_WDN), rb * 32, kb * 64, scr, lane, false); }
    }
    __syncthreads();
    float* wt = (float*)lds;
    float* tc = (float*)(lds + 64 * 129 * 4);
    for (int it = get_bid(); it < 256; it += get_nblk()) {
        const int g = (it & 63) >> 4, kb = it & 15, qtr = it >> 6;
        __syncthreads();
        if (tid < 128) { const float fr = (float)tid * (1.f / 128.f); tc[tid] = __builtin_amdgcn_cosf(fr) * 0.08838834764831845f; tc[128 + tid] = __builtin_amdgcn_sinf(fr) * 0.08838834764831845f; }
        for (int e = tid; e < 64 * 128; e += NTH) { const int kk = e >> 7, c = e & 127; wt[kk * 129 + c] = w_in[(size_t)(kb * 64 + kk) * INC + g * 128 + c]; }
        __syncthreads();
        const int kk = tid & 63;
        for (int o = qtr * 64 + (tid >> 6); o < qtr * 64 + 64; o += 8) {
            const int part = o >> 7, j = o & 127; float s = 0.f;
            for (int c = 0; c < 128; ++c) s += wt[kk * 129 + c] * tc[part * 128 + ((c * j) & 127)];
            ((bf16_t*)(ws + O_WIN))[(size_t)(part * 512 + g * 128 + j) * 1024 + kb * 64 + kk] = (bf16_t)bfbits(s);
        }
    }
    __syncthreads();
}

DI void convert_cache(const Params& p, int l) {
    const int gt = get_bid() * NTH + get_tid(), ng = get_nblk() * NTH;
    bf16_t* KDLp = (bf16_t*)(p.ws + O_KDL); bf16_t* VTLp = (bf16_t*)(p.ws + O_VTL);
    for (int e = gt; e < NB_L * 256 * 128; e += ng) {
        const int b = e / (256 * 128), r = e % (256 * 128), pos = r >> 7, c4 = (r & 127) * 4;
        const float4 v = *(const float4*)(p.in[3] + (((size_t)b * DEPTH + l) * 256 + pos) * 512 + c4);
        u32x2 o; o.x = pk2(v.x, v.y); o.y = pk2(v.z, v.w);
        *(u32x2*)(KDLp + ((size_t)b * KL + 4096 + pos) * 512 + c4) = o;
    }
    for (int e = gt; e < NB_L * 512 * 256; e += ng) {
        const int b = e / (512 * 256), r = e % (512 * 256), col = r >> 8, pos = r & 255;
        const float v = p.in[4][(((size_t)b * DEPTH + l) * 256 + pos) * 512 + col];
        VTLp[((size_t)b * 512 + col) * KL + 4096 + pos] = (bf16_t)bfbits(v);
    }
}

DI void phase_prep(const Params& p, unsigned char* lds) {
    const int tid = get_tid();
    unsigned char* ws = p.ws;
    {
        float* sl = (float*)lds;
        for (int it = get_bid(); it < DEPTH * 16 * 12; it += get_nblk()) {
            const int l = it / 192, q = it % 192, kc = q / 12, nb = q % 12;
            __syncthreads();
            for (int e = tid; e < 9 * 64; e += NTH) { const int r = e >> 6, k = kc * 64 + (e & 63); const float c = r == 0 ? p.in[6][k] : p.in[2][(r - 1) * 1024 + k]; sl[e] = siluf_(c); }
            __syncthreads();
            const int n = nb * 512 + tid; float a[9];
#pragma unroll
            for (int r = 0; r < 9; ++r) a[r] = 0.f;
            const float* wm = p.in[7] + ((size_t)l * 1024 + kc * 64) * 6144 + n;
#pragma unroll 4
            for (int k = 0; k < 64; ++k) { const float wv = wm[(size_t)k * 6144];
#pragma unroll
                for (int r = 0; r < 9; ++r) a[r] += sl[r * 64 + k] * wv; }
            float* mp = (float*)(ws + O_MODP) + (((size_t)kc * DEPTH + l) * 9) * 6144 + n;
#pragma unroll
            for (int r = 0; r < 9; ++r) mp[(size_t)r * 6144] = a[r];
        }
    }
    {
        const int gt = get_bid() * NTH + tid, ng = get_nblk() * NTH;
        bf16_t* DLp = (bf16_t*)(ws + O_DL);
        for (int e = gt; e < 2048 * 1024; e += ng) {
            const int s = e >> 10, t8 = (e & 1023) * 8; float v[8];
#pragma unroll
            for (int j = 0; j < 8; ++j) { const int t = t8 + j; const int tt = t & 4095; const float fr = (float)((s * tt) & 4095) * (1.f / 4096.f);
                v[j] = (t < 4096 ? __builtin_amdgcn_cosf(fr) : -__builtin_amdgcn_sinf(fr)) * (1.f / 64.f); }
            u32x4 o; o.x = pk2(v[0], v[1]); o.y = pk2(v[2], v[3]); o.z = pk2(v[4], v[5]); o.w = pk2(v[6], v[7]);
            *(u32x4*)(DLp + (size_t)s * 8192 + t8) = o;
        }
        bf16_t* DCp = (bf16_t*)(ws + O_DC);
        for (int e = gt; e < 256 * 512; e += ng) {
            const int s = e >> 9, t = e & 511, tt = t & 255; const float fr = (float)((s * tt) & 255) * (1.f / 256.f);
            DCp[e] = (bf16_t)bfbits((t < 256 ? __builtin_amdgcn_cosf(fr) : -__builtin_amdgcn_sinf(fr)) * (1.f / 16.f));
        }
        float2* rope = (float2*)(ws + O_ROPE);
        for (int e = gt; e < 1024; e += ng) {
            const int pos = e >> 4, f = e & 15; const float ang = (float)pos * exp2f(-(float)f * 0.8304820237218406f);
            double rev = (double)ang * 0.15915494309189535; rev -= floor(rev); const float fr = (float)rev;
            rope[e] = make_float2(__builtin_amdgcn_cosf(fr), __builtin_amdgcn_sinf(fr));
        }
        if (gt < DEPTH) {
            const float* lp = p.in[16] + gt * 256; float s1 = 0.f, s2 = 0.f;
            for (int i = 0; i < 64; ++i) { s1 += lp[i] * lp[64 + i]; s2 += lp[128 + i] * lp[192 + i]; }
            ((float*)(ws + O_LAM))[gt] = expf(s1) - expf(s2) + lam_init_f(gt);
        }
    }
    convert_weights(p, 0, lds);
    convert_cache(p, 0);
}

DI void phase_modreduce(const Params& p) {
    const int gt = get_bid() * NTH + get_tid(), ng = get_nblk() * NTH;
    float* mod = (float*)(p.ws + O_MOD); const float* mp = (const float*)(p.ws + O_MODP);
    for (int e = gt; e < DEPTH * 9 * 6144; e += ng) {
        const int l = e / (9 * 6144), n = e % 6144; float s = p.in[8][l * 6144 + n];
        for (int kc = 0; kc < 16; ++kc) s += mp[(size_t)kc * DEPTH * 9 * 6144 + e];
        mod[e] = s;
    }
}

DI void phase_norm(const Params& p, int l, int which, size_t dst_off) {
    const int lane = get_tid() & 63, gw = get_bid() * 8 + (get_tid() >> 6), ngw = get_nblk() * 8;
    const float* n9 = p.in[9]; const float* n10 = p.in[10]; const float* nw = (which ? n10 : n9) + l * 1024;
    const float* mod = (const float*)(p.ws + O_MOD) + (size_t)l * 9 * 6144;
    bf16_t* HB = (bf16_t*)(p.ws + dst_off);
    u32x4 vn[4];
    if (gw < NTOK) { const float* xr = which ? p.out + (size_t)gw * 1024 : xrow_ptr(p, l, gw);
#pragma unroll
        for (int j = 0; j < 4; ++j) vn[j] = gld16(xr + j * 256 + lane * 4); }
    for (int tok = gw; tok < NTOK; tok += ngw) {
        u32x4 vc[4];
#pragma unroll
        for (int j = 0; j < 4; ++j) vc[j] = vn[j];
        if (tok + ngw < NTOK) { const int tn = tok + ngw; const float* xr = which ? p.out + (size_t)tn * 1024 : xrow_ptr(p, l, tn);
#pragma unroll
            for (int j = 0; j < 4; ++j) vn[j] = gld16(xr + j * 256 + lane * 4); }
        const float* mr = mod + (size_t)tok_r(tok) * 6144 + (which ? 3072 : 0);
        float4 v[4]; float s = 0.f;
#pragma unroll
        for (int j = 0; j < 4; ++j) { v[j] = make_float4(__uint_as_float(vc[j].x), __uint_as_float(vc[j].y), __uint_as_float(vc[j].z), __uint_as_float(vc[j].w));
            s += v[j].x * v[j].x + v[j].y * v[j].y + v[j].z * v[j].z + v[j].w * v[j].w; }
        s = wave_sum(s); const float rstd = rsqrtf(s * (1.f / 1024.f) + 1e-6f);
#pragma unroll
        for (int j = 0; j < 4; ++j) {
            const int k = j * 256 + lane * 4;
            const float4 g = *(const float4*)(nw + k), sh = *(const float4*)(mr + k), sc = *(const float4*)(mr + 1024 + k);
            u32x2 o; o.x = pk2(v[j].x * rstd * g.x * (1.f + sc.x) + sh.x, v[j].y * rstd * g.y * (1.f + sc.y) + sh.y);
            o.y = pk2(v[j].z * rstd * g.z * (1.f + sc.z) + sh.z, v[j].w * rstd * g.w * (1.f + sc.w) + sh.w);
            *(u32x2*)(HB + (size_t)tok * 1024 + k) = o;
        }
    }
}

DI void g1_tile(const Params& p, int l, int mtile, int ntile, unsigned char* lds) {
    const int tid = get_tid(), lane = tid & 63, w = tid >> 6, wm = w >> 1, wn = w & 1, lh = lane >> 5, l31 = lane & 31;
    unsigned char* ws = p.ws;
    f32x16 acc[2][4]; acc_zero<4>(acc);
    const int m0 = mtile * 256;
    ALoadBF al{(const bf16_t*)(ws + O_HB) + (size_t)m0 * 1024, 1024};
    gemm_kloop<4>(acc, al, (const bf16_t*)(ws + O_WIN) + (size_t)ntile * 256 * 1024, 1024, 1024, lds);
    const bool ctx = m0 < NCTXTOK;
    const int tb0 = tok_batch0(m0);
    const int T = ctx ? TC : TL;
    const int bidx = ctx ? (m0 >> 8) : ((m0 - NCTXTOK) >> 12);
#pragma unroll
    for (int pr = 0; pr < 2; ++pr) {
    const int colbase = ntile * 256 + wn * 128 + pr * 64; const int seg = colbase >> 7; const int n0 = seg * 128; const int wn_ = (colbase >> 6) & 1;
    if (seg < 8) {
        bf16_t* zt = (bf16_t*)(ws + O_ZT) + (size_t)tb0 * 1024;
#pragma unroll
        for (int mt = 0; mt < 2; ++mt) { const int t = m0 + wm * 64 + mt * 32 + l31 - tb0;
#pragma unroll
            for (int nt = 0; nt < 2; ++nt)
#pragma unroll
                for (int r = 0; r < 16; ++r) { const int c = n0 + wn_ * 64 + nt * 32 + (r >> 2) * 8 + lh * 4 + (r & 3); const int part = c >> 9, n = c & 511;
                    zt[(size_t)n * (2 * T) + part * T + t] = (bf16_t)bfbits(acc[mt][2 * pr + nt][r]); } }
    } else if (seg < 12 || (seg >= 16 && seg < 20)) {
        bf16_t* dst; int cb, ld; float sc = 1.f;
        if (seg < 10) { dst = (bf16_t*)(ws + O_QG); cb = n0 - 1024; ld = 256; sc = 0.125f; }
        else if (seg < 12) { dst = (bf16_t*)(ws + O_KG); cb = n0 - 1280; ld = 256; }
        else { dst = (bf16_t*)(ws + O_RG); cb = n0 - 2048; ld = 512; }
#pragma unroll
        for (int mt = 0; mt < 2; ++mt) { const int row = m0 + wm * 64 + mt * 32 + l31;
#pragma unroll
            for (int nt = 0; nt < 2; ++nt)
#pragma unroll
                for (int gp = 0; gp < 2; ++gp) { const int c = cb + wn_ * 64 + nt * 32 + gp * 16; const int g0 = 2 * gp, g1 = 2 * gp + 1; u32x2 oa, ob;
                    oa.x = pk2(acc[mt][2 * pr + nt][4 * g0] * sc, acc[mt][2 * pr + nt][4 * g0 + 1] * sc); oa.y = pk2(acc[mt][2 * pr + nt][4 * g0 + 2] * sc, acc[mt][2 * pr + nt][4 * g0 + 3] * sc);
                    ob.x = pk2(acc[mt][2 * pr + nt][4 * g1] * sc, acc[mt][2 * pr + nt][4 * g1 + 1] * sc); ob.y = pk2(acc[mt][2 * pr + nt][4 * g1 + 2] * sc, acc[mt][2 * pr + nt][4 * g1 + 3] * sc);
                    st_pair16(dst + (size_t)row * ld + c, oa, ob, lh); } }
    } else if (seg < 16) {
        bf16_t* vt = (bf16_t*)(ws + O_VGT) + (size_t)tb0 * 512;
#pragma unroll
        for (int mt = 0; mt < 2; ++mt) { const int t = m0 + wm * 64 + mt * 32 + l31 - tb0;
#pragma unroll
            for (int nt = 0; nt < 2; ++nt)
#pragma unroll
                for (int r = 0; r < 16; ++r) { const int c = n0 - 1536 + wn_ * 64 + nt * 32 + (r >> 2) * 8 + lh * 4 + (r & 3);
                    vt[(size_t)c * T + t] = (bf16_t)bfbits(acc[mt][2 * pr + nt][r]); } }
    } else if (seg == 20) {
        if (wn_ == 0) { float* ag = (float*)(ws + O_AG);
#pragma unroll
            for (int mt = 0; mt < 2; ++mt) { const int row = m0 + wm * 64 + mt * 32 + l31;
#pragma unroll
                for (int g = 0; g < 4; ++g) { const int c = g * 8 + lh * 4;
                    *(float4*)(ag + (size_t)row * 32 + c) = make_float4(acc[mt][2 * pr][4 * g], acc[mt][2 * pr][4 * g + 1], acc[mt][2 * pr][4 * g + 2], acc[mt][2 * pr][4 * g + 3]); } } }
    } else if (seg < 29) {
        const bool isq = seg < 25;
        const int cb = (isq ? n0 - 2688 : n0 - 3200) + wn_ * 64;
        const float* gain = p.in[15] + (l * 2 + (isq ? 0 : 1)) * 64;
        const float2* rope = (const float2*)(ws + O_ROPE);
#pragma unroll
        for (int mt = 0; mt < 2; ++mt) {
            const int row = m0 + wm * 64 + mt * 32 + l31; const int t = row - tb0;
            float ss = 0.f;
#pragma unroll
            for (int nt = 0; nt < 2; ++nt)
#pragma unroll
                for (int r = 0; r < 16; ++r) ss += acc[mt][2 * pr + nt][r] * acc[mt][2 * pr + nt][r];
            ss += __shfl_xor(ss, 32);
            const float rstd = rsqrtf(ss * (1.f / 64.f) + 1e-6f);
            float y[2][16];
#pragma unroll
            for (int nt = 0; nt < 2; ++nt)
#pragma unroll
                for (int r = 0; r < 16; ++r) { const int d = nt * 32 + (r >> 2) * 8 + lh * 4 + (r & 3); y[nt][r] = acc[mt][2 * pr + nt][r] * rstd * gain[d]; }
            if (!ctx) {
#pragma unroll
                for (int nt = 0; nt < 2; ++nt) { const int pos = nt == 0 ? (t >> 6) : (t & 63);
#pragma unroll
                    for (int r = 0; r < 8; ++r) { const int f = ((r >> 2) & 1) * 8 + lh * 4 + (r & 3); const float2 cs = rope[pos * 16 + f];
                        const float y0 = y[nt][r], y1 = y[nt][r + 8]; y[nt][r] = y0 * cs.x - y1 * cs.y; y[nt][r + 8] = y1 * cs.x + y0 * cs.y; } }
            }
            if (isq) {
                bf16_t* qd = (bf16_t*)(ws + O_QD) + (size_t)row * 512 + cb; const float qs = 0.125f * 1.4426950408889634f;
#pragma unroll
                for (int nt = 0; nt < 2; ++nt)
#pragma unroll
                    for (int gp = 0; gp < 2; ++gp) { const int g0 = 2 * gp, g1 = 2 * gp + 1; u32x2 oa, ob;
                        oa.x = pk2(y[nt][4 * g0] * qs, y[nt][4 * g0 + 1] * qs); oa.y = pk2(y[nt][4 * g0 + 2] * qs, y[nt][4 * g0 + 3] * qs);
                        ob.x = pk2(y[nt][4 * g1] * qs, y[nt][4 * g1 + 1] * qs); ob.y = pk2(y[nt][4 * g1 + 2] * qs, y[nt][4 * g1 + 3] * qs);
                        st_pair16(qd + nt * 32 + gp * 16, oa, ob, lh); }
            } else {
                bf16_t* kd = ctx ? (bf16_t*)(ws + O_KDC) + ((size_t)bidx * 256 + t) * 512 + cb : (bf16_t*)(ws + O_KDL) + ((size_t)bidx * KL + t) * 512 + cb;
#pragma unroll
                for (int nt = 0; nt < 2; ++nt)
#pragma unroll
                    for (int gp = 0; gp < 2; ++gp) { const int g0 = 2 * gp, g1 = 2 * gp + 1; u32x2 oa, ob;
                        oa.x = pk2(y[nt][4 * g0], y[nt][4 * g0 + 1]); oa.y = pk2(y[nt][4 * g0 + 2], y[nt][4 * g0 + 3]);
                        ob.x = pk2(y[nt][4 * g1], y[nt][4 * g1 + 1]); ob.y = pk2(y[nt][4 * g1 + 2], y[nt][4 * g1 + 3]);
                        st_pair16(kd + nt * 32 + gp * 16, oa, ob, lh); }
                if (ctx) { float* ok = p.out + OUT_CK + (((size_t)bidx * DEPTH + l) * 256 + t) * 512 + cb;
#pragma unroll
                    for (int nt = 0; nt < 2; ++nt)
#pragma unroll
                        for (int g = 0; g < 4; ++g) *(float4*)(ok + nt * 32 + g * 8 + lh * 4) = make_float4(y[nt][4 * g], y[nt][4 * g + 1], y[nt][4 * g + 2], y[nt][4 * g + 3]); }
            }
        }
    } else if (seg < 33) {
        const int Tk = ctx ? 256 : KL;
        bf16_t* vt = ctx ? (bf16_t*)(ws + O_VTC) + (size_t)bidx * 512 * 256 : (bf16_t*)(ws + O_VTL) + (size_t)bidx * 512 * KL;
#pragma unroll
        for (int mt = 0; mt < 2; ++mt) { const int row = m0 + wm * 64 + mt * 32 + l31; const int t = row - tb0;
#pragma unroll
            for (int nt = 0; nt < 2; ++nt) {
#pragma unroll
                for (int r = 0; r < 16; ++r) { const int c = n0 - 3712 + wn_ * 64 + nt * 32 + (r >> 2) * 8 + lh * 4 + (r & 3);
                    vt[(size_t)c * Tk + t] = (bf16_t)bfbits(acc[mt][2 * pr + nt][r]); }
                if (ctx) { float* ov = p.out + OUT_CV + (((size_t)bidx * DEPTH + l) * 256 + t) * 512 + (n0 - 3712) + wn_ * 64 + nt * 32;
#pragma unroll
                    for (int g = 0; g < 4; ++g) *(float4*)(ov + g * 8 + lh * 4) = make_float4(acc[mt][2 * pr + nt][4 * g], acc[mt][2 * pr + nt][4 * g + 1], acc[mt][2 * pr + nt][4 * g + 2], acc[mt][2 * pr + nt][4 * g + 3]); }
            } }
    }
    }
}

DI void dft_tile(const Params& p, bool ctx, int b, int mt_, int nt_, unsigned char* lds) {
    const int tid = get_tid(), lane = tid & 63, w = tid >> 6, wm = w >> 1, wn = w & 1, lh = lane >> 5, l31 = lane & 31;
    unsigned char* ws = p.ws;
    const int T = ctx ? TC : TL; const int tb0 = ctx ? b * 256 : NCTXTOK + b * 4096;
    f32x16 acc[2][2]; acc_zero<2>(acc);
    ALoadBF al{(const bf16_t*)(ws + (ctx ? O_DC : O_DL)) + (size_t)mt_ * 256 * (2 * T), 2 * T};
    gemm_kloop<2, false>(acc, al, (const bf16_t*)(ws + O_ZT) + (size_t)tb0 * 1024 + (size_t)nt_ * 128 * (2 * T), 2 * T, 2 * T, lds);
    bf16_t* yf = (bf16_t*)(ws + O_HB);
#pragma unroll
    for (int mt = 0; mt < 2; ++mt) { const int row = tb0 + mt_ * 256 + wm * 64 + mt * 32 + l31;
#pragma unroll
        for (int nt = 0; nt < 2; ++nt)
#pragma unroll
            for (int g = 0; g < 4; ++g) { const int c = nt_ * 128 + wn * 64 + nt * 32 + g * 8 + lh * 4;
                u32x2 o; o.x = pk2(acc[mt][nt][4 * g], acc[mt][nt][4 * g + 1]); o.y = pk2(acc[mt][nt][4 * g + 2], acc[mt][nt][4 * g + 3]);
                *(u32x2*)(yf + (size_t)row * 512 + c) = o; } }
}

DI void dft_lat_tile(const Params& p, int b, int mt_, int nt_, unsigned char* lds) {
    const int tid = get_tid(), lane = tid & 63, w = tid >> 6, wm = w >> 1, wn = w & 1, lh = lane >> 5, l31 = lane & 31;
    unsigned char* ws = p.ws;
    const int tb0 = NCTXTOK + b * 4096;
    const bf16_t* D = (const bf16_t*)(ws + O_DL) + (size_t)mt_ * 256 * 8192;
    const bf16_t* Z = (const bf16_t*)(ws + O_ZT) + (size_t)tb0 * 1024 + (size_t)nt_ * 128 * 8192;
    bf16_t* yf = (bf16_t*)(ws + O_HB);
    f32x16 ac[2][2], as[2][2]; acc_zero<2>(ac); acc_zero<2>(as);
    { ALoadBF alc{D, 8192}; gemm_kloop<2>(ac, alc, Z, 8192, 4096, lds); }
    { ALoadBF als{D + 4096, 8192}; gemm_kloop<2>(as, als, Z + 4096, 8192, 4096, lds); }
#pragma unroll
    for (int mt = 0; mt < 2; ++mt)
#pragma unroll
        for (int nt = 0; nt < 2; ++nt)
#pragma unroll
            for (int r = 0; r < 16; ++r) { const float c_ = ac[mt][nt][r], s_ = as[mt][nt][r]; ac[mt][nt][r] = c_ + s_; as[mt][nt][r] = c_ - s_; }
#pragma unroll
    for (int mt = 0; mt < 2; ++mt) { const int srow = mt_ * 256 + wm * 64 + mt * 32 + l31;
#pragma unroll
        for (int nt = 0; nt < 2; ++nt)
#pragma unroll
            for (int gp = 0; gp < 2; ++gp) { const int c = nt_ * 128 + wn * 64 + nt * 32 + gp * 16; const int g0 = 2 * gp, g1 = 2 * gp + 1;
                u32x2 oa, ob, ma, mb;
                oa.x = pk2(ac[mt][nt][4 * g0], ac[mt][nt][4 * g0 + 1]); oa.y = pk2(ac[mt][nt][4 * g0 + 2], ac[mt][nt][4 * g0 + 3]);
                ob.x = pk2(ac[mt][nt][4 * g1], ac[mt][nt][4 * g1 + 1]); ob.y = pk2(ac[mt][nt][4 * g1 + 2], ac[mt][nt][4 * g1 + 3]);
                ma.x = pk2(as[mt][nt][4 * g0], as[mt][nt][4 * g0 + 1]); ma.y = pk2(as[mt][nt][4 * g0 + 2], as[mt][nt][4 * g0 + 3]);
                mb.x = pk2(as[mt][nt][4 * g1], as[mt][nt][4 * g1 + 1]); mb.y = pk2(as[mt][nt][4 * g1 + 2], as[mt][nt][4 * g1 + 3]);
                st_pair16(yf + (size_t)(tb0 + srow) * 512 + c, oa, ob, lh);
                st_pair16_if(yf + (size_t)(tb0 + 4096 - srow) * 512 + c, ma, mb, lh, srow > 0); } }
    if (mt_ == 0) {
        const int col = tid >> 2, q = tid & 3; const bf16_t* zr = Z + (size_t)col * 8192 + q * 1024; float sacc = 0.f;
#pragma unroll 4
        for (int i = 0; i < 128; ++i) { const u32x4 v = gld16(zr + i * 8); const unsigned vw[4] = {v.x, v.y, v.z, v.w};
#pragma unroll
            for (int e = 0; e < 4; ++e) sacc += bf2f(vw[e] & 0xffffu) - bf2f(vw[e] >> 16); }
        sacc += __shfl_xor(sacc, 1); sacc += __shfl_xor(sacc, 2);
        if (q == 0) yf[(size_t)(tb0 + 2048) * 512 + nt_ * 128 + col] = (bf16_t)bfbits(sacc * (1.f / 64.f));
    }
}

constexpr int A_KP = 272, A_VP = 136, A_KSZ = 64 * A_KP, A_VSZ = 128 * A_VP, A_STAGE = A_KSZ + A_VSZ;
DI void attn_tile(const Params& p, int l, bool ctx, int b, int h, int qb, unsigned char* lds) {
    const int tid = get_tid(), lane = tid & 63, w = tid >> 6, mp = w & 1, rq = w >> 1, lh = lane >> 5, l31 = lane & 31;
    unsigned char* ws = p.ws;
    const int Tk = ctx ? 256 : KL; const int tb0 = ctx ? b * 256 : NCTXTOK + b * 4096;
    const int tok0 = tb0 + qb * 128;
    const bf16_t* Kp = (ctx ? (const bf16_t*)(ws + O_KDC) + (size_t)b * 256 * 512 : (const bf16_t*)(ws + O_KDL) + (size_t)b * KL * 512) + h * 128;
    const bf16_t* Vp = ctx ? (const bf16_t*)(ws + O_VTC) + ((size_t)b * 512 + h * 128) * 256 : (const bf16_t*)(ws + O_VTL) + ((size_t)b * 512 + h * 128) * KL;
    bf16_t* QD = (bf16_t*)(ws + O_QD);
    bf16x8 qf[4];
    { const bf16_t* qp = QD + (size_t)(tok0 + rq * 32 + l31) * 512 + h * 128 + mp * 64 + lh * 8;
#pragma unroll
        for (int ks = 0; ks < 4; ++ks) qf[ks] = *(const bf16x8*)(qp + ks * 16); }
    f32x16 O[4];
#pragma unroll
    for (int v = 0; v < 4; ++v)
#pragma unroll
        for (int r = 0; r < 16; ++r) O[v][r] = 0.f;
    float m_run = -1e30f, l_run = 0.f;
    const int nkt = Tk >> 6;
    u32x4 rk[2], rv[2];
    const int kr = tid >> 4, kc = (tid & 15) * 8;
    const int vr = tid >> 3, vc = (tid & 7) * 8;
    __syncthreads();
#pragma unroll
    for (int i = 0; i < 2; ++i) { rk[i] = gld16(Kp + (size_t)(kr + 32 * i) * 512 + kc); rv[i] = gld16(Vp + (size_t)(vr + 64 * i) * Tk + vc); }
#pragma unroll
    for (int i = 0; i < 2; ++i) { *(u32x4*)(lds + (kr + 32 * i) * A_KP + kc * 2) = rk[i]; { u32x2 lo_, hi_; lo_.x = rv[i].x; lo_.y = rv[i].y; hi_.x = rv[i].z; hi_.y = rv[i].w; *(u32x2*)(lds + A_KSZ + (vr + 64 * i) * A_VP + vc * 2) = lo_; *(u32x2*)(lds + A_KSZ + (vr + 64 * i) * A_VP + vc * 2 + 8) = hi_; } }
    if (nkt > 1) {
#pragma unroll
        for (int i = 0; i < 2; ++i) { rk[i] = gld16(Kp + (size_t)(64 + kr + 32 * i) * 512 + kc); rv[i] = gld16(Vp + (size_t)(vr + 64 * i) * Tk + 64 + vc); } }
    LBAR();
    for (int kt = 0; kt < nkt; ++kt) {
        unsigned char* cur = lds + (kt & 1) * A_STAGE; unsigned char* nxt = lds + ((kt + 1) & 1) * A_STAGE;
        if (kt + 1 < nkt) {
#pragma unroll
            for (int i = 0; i < 2; ++i) { *(u32x4*)(nxt + (kr + 32 * i) * A_KP + kc * 2) = rk[i]; { u32x2 lo_, hi_; lo_.x = rv[i].x; lo_.y = rv[i].y; hi_.x = rv[i].z; hi_.y = rv[i].w; *(u32x2*)(nxt + A_KSZ + (vr + 64 * i) * A_VP + vc * 2) = lo_; *(u32x2*)(nxt + A_KSZ + (vr + 64 * i) * A_VP + vc * 2 + 8) = hi_; } } }
        if (kt + 2 < nkt) { const int key0 = (kt + 2) * 64;
#pragma unroll
            for (int i = 0; i < 2; ++i) { rk[i] = gld16(Kp + (size_t)(key0 + kr + 32 * i) * 512 + kc); rv[i] = gld16(Vp + (size_t)(vr + 64 * i) * Tk + key0 + vc); } }
        __builtin_amdgcn_sched_barrier(0);
        f32x16 S[2];
#pragma unroll
        for (int s = 0; s < 2; ++s)
#pragma unroll
            for (int r = 0; r < 16; ++r) S[s][r] = 0.f;
        {
            bf16x8 kf[4][2];
#pragma unroll
            for (int ks = 0; ks < 4; ++ks)
#pragma unroll
                for (int sub = 0; sub < 2; ++sub) kf[ks][sub] = *(const bf16x8*)(cur + (sub * 32 + l31) * A_KP + (mp * 64 + ks * 16 + lh * 8) * 2);
#pragma unroll
            for (int ks = 0; ks < 4; ++ks)
#pragma unroll
                for (int sub = 0; sub < 2; ++sub) S[sub] = MFMA32(kf[ks][sub], qf[ks], S[sub]);
        }
        u32x2 vlo[2][4], vhi[2][4];
        const unsigned char* vbase = cur + A_KSZ + l31 * A_VP + 8 * lh;
#pragma unroll
        for (int v = 0; v < 4; ++v) { vlo[0][v] = *(const u32x2*)(vbase + v * 32 * A_VP); vhi[0][v] = *(const u32x2*)(vbase + v * 32 * A_VP + 16); }
        float mx = S[0][0];
#pragma unroll
        for (int sub = 0; sub < 2; ++sub)
#pragma unroll
            for (int r = 0; r < 16; ++r) mx = fmaxf(mx, S[sub][r]);
        mx = fmaxf(mx, __shfl_xor(mx, 32));
        float alpha = 1.f;
        if (!__all(mx - m_run <= 8.f)) {
            const float mn = fmaxf(m_run, mx); alpha = __builtin_amdgcn_exp2f(m_run - mn); m_run = mn;
#pragma unroll
            for (int v = 0; v < 4; ++v)
#pragma unroll
                for (int r = 0; r < 16; ++r) O[v][r] *= alpha;
        }
        const float mnew = m_run;
        float ps = 0.f;
#pragma unroll
        for (int sub = 0; sub < 2; ++sub)
#pragma unroll
            for (int r = 0; r < 16; ++r) { const float e = __builtin_amdgcn_exp2f(S[sub][r] - mnew); S[sub][r] = e; ps += e; }
        l_run = l_run * alpha + ps;
#pragma unroll
        for (int g = 0; g < 4; ++g) {
            const int sub = g >> 1, s = g & 1;
            if (g < 3) {
                const int g1 = g + 1;
#pragma unroll
                for (int v = 0; v < 4; ++v) { vlo[g1 & 1][v] = *(const u32x2*)(vbase + v * 32 * A_VP + g1 * 32); vhi[g1 & 1][v] = *(const u32x2*)(vbase + v * 32 * A_VP + g1 * 32 + 16); }
            }
            u32x4 pw; pw.x = pk2(S[sub][8 * s], S[sub][8 * s + 1]); pw.y = pk2(S[sub][8 * s + 2], S[sub][8 * s + 3]);
            pw.z = pk2(S[sub][8 * s + 4], S[sub][8 * s + 5]); pw.w = pk2(S[sub][8 * s + 6], S[sub][8 * s + 7]);
            const bf16x8 pf = __builtin_bit_cast(bf16x8, pw);
#pragma unroll
            for (int v = 0; v < 4; ++v) {
                u32x4 vw; vw.x = vlo[g & 1][v].x; vw.y = vlo[g & 1][v].y; vw.z = vhi[g & 1][v].x; vw.w = vhi[g & 1][v].y;
                O[v] = MFMA32(__builtin_bit_cast(bf16x8, vw), pf, O[v]);
            }
        }
        LBAR();
    }
    const float lt = l_run + __shfl_xor(l_run, 32); const float inv = 1.f / lt;
    float* os = (float*)lds;
    if (mp == 1) {
#pragma unroll
        for (int v = 0; v < 4; ++v)
#pragma unroll
            for (int r = 0; r < 16; ++r) os[((rq * 64 + v * 16 + r) << 6) + lane] = O[v][r] * inv;
    }
    __syncthreads();
    if (mp == 0) {
        const float lam = ((const float*)(ws + O_LAM))[l];
        float ss = 0.f;
#pragma unroll
        for (int v = 0; v < 4; ++v)
#pragma unroll
            for (int r = 0; r < 16; ++r) { const float o = O[v][r] * inv - lam * os[((rq * 64 + v * 16 + r) << 6) + lane]; O[v][r] = o; ss += o * o; }
        ss += __shfl_xor(ss, 32);
        const float rstd = rsqrtf(ss * (1.f / 128.f) + 1e-6f) * (1.f - lam_init_f(l));
        const float* gn = p.in[17] + l * 128;
        bf16_t* od = QD + (size_t)(tok0 + rq * 32 + l31) * 512 + h * 128;
#pragma unroll
        for (int v = 0; v < 4; ++v)
#pragma unroll
            for (int gp = 0; gp < 2; ++gp) { u32x2 ob[2];
#pragma unroll
                for (int h2 = 0; h2 < 2; ++h2) { const int g = 2 * gp + h2; const int c = v * 32 + g * 8 + lh * 4; const float4 gg = *(const float4*)(gn + c);
                    ob[h2].x = pk2(O[v][4 * g] * rstd * gg.x, O[v][4 * g + 1] * rstd * gg.y); ob[h2].y = pk2(O[v][4 * g + 2] * rstd * gg.z, O[v][4 * g + 3] * rstd * gg.w); }
                st_pair16(od + v * 32 + gp * 16, ob[0], ob[1], lh); }
    }
    __syncthreads();
}

constexpr int GP = 144;
constexpr int GL_QT = 0, GL_KT = 64 * GP, GL_KDT = 2 * 64 * GP, GL_ATT = 3 * 64 * GP, GL_VT = 4 * 64 * GP, GL_CUM = GL_VT + 128 * GP, GL_DIR = GL_CUM + 64 * 65 * 4;
constexpr int GL_W2 = GL_DIR;
static_assert(GL_W2 + 4352 <= LDS_BYTES - 64, "gla lds");
DI void gla_chain(const Params& p, int l, bool ctx, int b, int h, int dir, unsigned char* lds) {
    const int tid = get_tid(), lane = tid & 63, w = tid >> 6, vs = w & 3, ih = w >> 2, lh = lane >> 5, l31 = lane & 31;
    unsigned char* ws = p.ws;
    const int T = ctx ? TC : TL; const int tb0 = ctx ? b * 256 : NCTXTOK + b * 4096; const int nch = T >> 6;
    const bf16_t* QG = (const bf16_t*)(ws + O_QG); const bf16_t* KG = (const bf16_t*)(ws + O_KG);
    const bf16_t* VGT = (const bf16_t*)(ws + O_VGT) + (size_t)tb0 * 512 + (size_t)h * 128 * T;
    const float* AG = (const float*)(ws + O_AG);
    bf16_t* OGd = dir ? (bf16_t*)(ws + O_OGB) : (bf16_t*)(ws + O_HB) + (size_t)NTOK * 512;
    const float* w2 = p.in[12] + ((size_t)(l * 2 + dir) * 16) * 256 + h * 64;
    const float* ba = p.in[13] + (l * 2 + dir) * 256 + h * 64;
    float* cum = (float*)(lds + GL_CUM);
    float* agl = (float*)lds;
    float* w2l = (float*)(lds + GL_W2);
    f32x16 S[2];
    if (ctx) {
#pragma unroll
        for (int k2 = 0; k2 < 2; ++k2)
#pragma unroll
            for (int r = 0; r < 16; ++r) S[k2][r] = 0.f;
    } else {
        const float* s0 = p.in[5] + ((((size_t)b * DEPTH + l) * 2 + dir) * 4 + h) * 64 * 128;
#pragma unroll
        for (int k2 = 0; k2 < 2; ++k2)
#pragma unroll
            for (int r = 0; r < 16; ++r) S[k2][r] = s0[(size_t)(k2 * 32 + (r >> 2) * 8 + lh * 4 + (r & 3)) * 128 + vs * 32 + l31];
    }
    __syncthreads();
    for (int e = tid; e < 16 * 64; e += NTH) w2l[e] = w2[(e >> 6) * 256 + (e & 63)];
    if (tid < 64) w2l[1024 + tid] = ba[tid];
    const int jr = tid >> 3, kseg = (tid & 7) * 8;
    const int vrow = tid >> 2, vseg = (tid & 3) * 16;
    const int jlast = dir ? 0 : 63;
    u32x4 nq, nk, nvv[2]; f32v2 na2;
    { const int c0 = dir ? nch - 1 : 0; const int tk = tb0 + c0 * 64;
      nq = gld16(QG + (size_t)(tk + jr) * 256 + h * 64 + kseg); nk = gld16(KG + (size_t)(tk + jr) * 256 + h * 64 + kseg);
      const bf16_t* vp = VGT + (size_t)vrow * T + c0 * 64 + vseg; nvv[0] = gld16(vp); nvv[1] = gld16(vp + 8);
      na2 = *(const GAS f32v2*)(AG + (size_t)(tk + jr) * 32 + dir * 16 + (tid & 7) * 2); }
#pragma unroll 1
    for (int s = 0; s < nch; ++s) {
        const int c = dir ? nch - 1 - s : s; const int t0 = c * 64; const int tokc = tb0 + t0;
        LBAR();
        const u32x4 q0 = nq, k0 = nk;
        *(f32v2*)(agl + jr * 16 + (tid & 7) * 2) = na2;
        *(u32x4*)(lds + GL_VT + vrow * GP + vseg * 2) = nvv[0]; *(u32x4*)(lds + GL_VT + vrow * GP + vseg * 2 + 16) = nvv[1];
        if (s + 1 < nch) { const int c1 = dir ? c - 1 : c + 1; const int tk = tb0 + c1 * 64;
            nq = gld16(QG + (size_t)(tk + jr) * 256 + h * 64 + kseg); nk = gld16(KG + (size_t)(tk + jr) * 256 + h * 64 + kseg);
            const bf16_t* vp = VGT + (size_t)vrow * T + c1 * 64 + vseg; nvv[0] = gld16(vp); nvv[1] = gld16(vp + 8);
            na2 = *(const GAS f32v2*)(AG + (size_t)(tk + jr) * 32 + dir * 16 + (tid & 7) * 2); }
        LBAR();
        { const int k = tid & 63, jg = tid >> 6; float wc[16];
#pragma unroll
          for (int r = 0; r < 16; ++r) wc[r] = w2l[r * 64 + k];
          const float bk = w2l[1024 + k];
#pragma unroll 1
          for (int jj = 0; jj < 8; ++jj) { const int j = jg * 8 + jj; float z = bk;
#pragma unroll
              for (int r = 0; r < 16; ++r) z += agl[j * 16 + r] * wc[r];
              const float ls = fminf(z, 0.f) - __logf(1.f + __expf(-fabsf(z)));
              cum[j * 65 + k] = ls * (1.f / 16.f); } }
        LBAR();
        if (tid < 64) { float a = 0.f;
            if (dir == 0) {
#pragma unroll 8
                for (int j = 0; j < 64; ++j) { a += cum[j * 65 + tid]; cum[j * 65 + tid] = a; } }
            else {
#pragma unroll 8
                for (int j = 63; j >= 0; --j) { a += cum[j * 65 + tid]; cum[j * 65 + tid] = a; } } }
        LBAR();
        { const unsigned qa[4] = {q0.x, q0.y, q0.z, q0.w}, ka[4] = {k0.x, k0.y, k0.z, k0.w};
          unsigned qo[4], ko[4];
#pragma unroll
          for (int e = 0; e < 4; ++e) {
              const int kk = kseg + 2 * e;
              const float c0 = cum[jr * 65 + kk], c1 = cum[jr * 65 + kk + 1], l0 = cum[jlast * 65 + kk], l1 = cum[jlast * 65 + kk + 1];
              const float qa0 = bf2f(qa[e] & 0xffffu), qa1 = bf2f(qa[e] >> 16), ka0 = bf2f(ka[e] & 0xffffu), ka1 = bf2f(ka[e] >> 16);
              qo[e] = pk2(qa0 * __expf(c0), qa1 * __expf(c1));
              ko[e] = pk2(ka0 * __expf(-c0), ka1 * __expf(-c1));
              *(bf16_t*)(lds + GL_KDT + kk * GP + jr * 2) = (bf16_t)bfbits(ka0 * __expf(l0 - c0));
              *(bf16_t*)(lds + GL_KDT + (kk + 1) * GP + jr * 2) = (bf16_t)bfbits(ka1 * __expf(l1 - c1));
          }
          u32x4 t; t.x = qo[0]; t.y = qo[1]; t.z = qo[2]; t.w = qo[3]; *(u32x4*)(lds + GL_QT + jr * GP + kseg * 2) = t;
          t.x = ko[0]; t.y = ko[1]; t.z = ko[2]; t.w = ko[3]; *(u32x4*)(lds + GL_KT + jr * GP + kseg * 2) = t; }
        LBAR();
        if (w < 4) { const int it = w >> 1, jt = w & 1; f32x16 at;
#pragma unroll
          for (int r = 0; r < 16; ++r) at[r] = 0.f;
#pragma unroll
          for (int ks = 0; ks < 4; ++ks) {
              const bf16x8 kf = *(const bf16x8*)(lds + GL_KT + (jt * 32 + l31) * GP + (ks * 16 + lh * 8) * 2);
              const bf16x8 qf = *(const bf16x8*)(lds + GL_QT + (it * 32 + l31) * GP + (ks * 16 + lh * 8) * 2);
              at = MFMA32(kf, qf, at); }
          const int i = it * 32 + l31;
#pragma unroll
          for (int g = 0; g < 4; ++g) { float v4[4];
#pragma unroll
              for (int e = 0; e < 4; ++e) { const int j = jt * 32 + g * 8 + lh * 4 + e; const bool keep = dir ? (j >= i) : (j <= i); v4[e] = keep ? at[4 * g + e] : 0.f; }
              u32x2 o; o.x = pk2(v4[0], v4[1]); o.y = pk2(v4[2], v4[3]);
              *(u32x2*)(lds + GL_ATT + i * GP + (jt * 32 + g * 8 + lh * 4) * 2) = o; } }
        LBAR();
        f32x16 oa;
#pragma unroll
        for (int r = 0; r < 16; ++r) oa[r] = 0.f;
        bf16x8 vf[4];
#pragma unroll
        for (int js = 0; js < 4; ++js) vf[js] = *(const bf16x8*)(lds + GL_VT + (vs * 32 + l31) * GP + (js * 16 + lh * 8) * 2);
#pragma unroll
        for (int js = 0; js < 4; ++js) {
            const bf16x8 af = *(const bf16x8*)(lds + GL_ATT + (ih * 32 + l31) * GP + (js * 16 + lh * 8) * 2);
            oa = MFMA32(af, vf[js], oa); }
#pragma unroll
        for (int k2 = 0; k2 < 2; ++k2)
#pragma unroll
            for (int s2 = 0; s2 < 2; ++s2) {
                u32x4 sw; sw.x = pk2(S[k2][8 * s2], S[k2][8 * s2 + 1]); sw.y = pk2(S[k2][8 * s2 + 2], S[k2][8 * s2 + 3]);
                sw.z = pk2(S[k2][8 * s2 + 4], S[k2][8 * s2 + 5]); sw.w = pk2(S[k2][8 * s2 + 6], S[k2][8 * s2 + 7]);
                const unsigned char* qp = lds + GL_QT + (ih * 32 + l31) * GP + (k2 * 32 + 16 * s2 + 4 * lh) * 2;
                const u32x2 lo = *(const u32x2*)qp, hi = *(const u32x2*)(qp + 16);
                u32x4 qw; qw.x = lo.x; qw.y = lo.y; qw.z = hi.x; qw.w = hi.y;
                oa = MFMA32(__builtin_bit_cast(bf16x8, qw), __builtin_bit_cast(bf16x8, sw), oa);
            }
#pragma unroll
        for (int k2 = 0; k2 < 2; ++k2) {
#pragma unroll
            for (int r = 0; r < 16; ++r) S[k2][r] *= __expf(cum[jlast * 65 + k2 * 32 + (r >> 2) * 8 + lh * 4 + (r & 3)]);
#pragma unroll
            for (int js = 0; js < 4; ++js) {
                const bf16x8 kf = *(const bf16x8*)(lds + GL_KDT + (k2 * 32 + l31) * GP + (js * 16 + lh * 8) * 2);
                S[k2] = MFMA32(kf, vf[js], S[k2]); }
        }
        { bf16_t* op = OGd + (size_t)(tokc + ih * 32 + lh * 4) * 512 + h * 128 + vs * 32 + l31;
#pragma unroll
          for (int r = 0; r < 16; ++r) ((GAS bf16_t*)op)[(size_t)((r >> 2) * 8 + (r & 3)) * 512] = (bf16_t)bfbits(oa[r]); }
    }
    if (ctx && ih == 0) {
        float* so = p.out + OUT_ST + ((((size_t)b * DEPTH + l) * 2 + dir) * 4 + h) * 64 * 128;
#pragma unroll
        for (int k2 = 0; k2 < 2; ++k2)
#pragma unroll
            for (int r = 0; r < 16; ++r) so[(size_t)(k2 * 32 + (r >> 2) * 8 + lh * 4 + (r & 3)) * 128 + vs * 32 + l31] = S[k2][r];
    }
    __syncthreads();
}

DI void gla_combine(const Params& p, int l) {
    const int lane = get_tid() & 63, gw = get_bid() * 8 + (get_tid() >> 6), ngw = get_nblk() * 8;
    bf16_t* OGF = (bf16_t*)(p.ws + O_HB) + (size_t)NTOK * 512; const bf16_t* OGB = (const bf16_t*)(p.ws + O_OGB); const bf16_t* RG = (const bf16_t*)(p.ws + O_RG);
    const float* gn = p.in[14] + l * 128 + (lane & 15) * 8;
    const float4 g0 = *(const float4*)gn, g1 = *(const float4*)(gn + 4);
    const float gg[8] = {g0.x, g0.y, g0.z, g0.w, g1.x, g1.y, g1.z, g1.w};
    u32x4 na, nb, nr;
    if (gw < NTOK) { const size_t o = (size_t)gw * 512 + lane * 8; na = gld16(OGF + o); nb = gld16(OGB + o); nr = gld16(RG + o); }
    for (int tok = gw; tok < NTOK; tok += ngw) {
        const size_t o = (size_t)tok * 512 + lane * 8;
        const u32x4 a = na, bq = nb, rr = nr;
        if (tok + ngw < NTOK) { const size_t o2 = (size_t)(tok + ngw) * 512 + lane * 8; na = gld16(OGF + o2); nb = gld16(OGB + o2); nr = gld16(RG + o2); }
        const unsigned aw[4] = {a.x, a.y, a.z, a.w}, bw[4] = {bq.x, bq.y, bq.z, bq.w}, rw[4] = {rr.x, rr.y, rr.z, rr.w};
        float v[8]; float ss = 0.f;
#pragma unroll
        for (int q = 0; q < 4; ++q) { v[2 * q] = bf2f(aw[q] & 0xffffu) + bf2f(bw[q] & 0xffffu); v[2 * q + 1] = bf2f(aw[q] >> 16) + bf2f(bw[q] >> 16); ss += v[2 * q] * v[2 * q] + v[2 * q + 1] * v[2 * q + 1]; }
        ss += __shfl_xor(ss, 1); ss += __shfl_xor(ss, 2); ss += __shfl_xor(ss, 4); ss += __shfl_xor(ss, 8);
        const float rstd = rsqrtf(ss * (1.f / 128.f) + 1e-6f);
        unsigned ow[4];
#pragma unroll
        for (int q = 0; q < 4; ++q) ow[q] = pk2(v[2 * q] * rstd * gg[2 * q] * siluf_(bf2f(rw[q] & 0xffffu)), v[2 * q + 1] * rstd * gg[2 * q + 1] * siluf_(bf2f(rw[q] >> 16)));
        u32x4 t; t.x = ow[0]; t.y = ow[1]; t.z = ow[2]; t.w = ow[3];
        *(u32x4*)(OGF + o) = t;
    }
}

DI unsigned xcc_id() { return (unsigned)__builtin_amdgcn_s_getreg((3 << 11) | 20) & 7u; }
DI int mtile_of(int x, int i) { return i < 2 ? 2 * x + i : 16 + 16 * x + (i - 2); }
template <class F>
DI void xcd_queue(const Params& p, int l, int slot, int per_xcd, unsigned char* lds, F f) {
    int* s_item = (int*)(lds + LDS_BYTES - 16);
    unsigned* cnt = (unsigned*)(p.ws + O_CNT) + (l * 6 + slot) * 8;
    const int x0 = (int)xcc_id();
    for (int dx = 0; dx < 8; ++dx) {
        const int x = (x0 + dx) & 7;
        for (;;) {
            __syncthreads();
            if (get_tid() == 0) *s_item = (int)atomicAdd(cnt + x, 1u);
            __syncthreads();
            const int j = *s_item;
            if (j >= per_xcd) break;
            f(x, j);
        }
    }
}
constexpr int MX_GL = 8, MX_GC = 16, MX_AL = 128, MX_FL = 32, MX_AC = 16, MX_FC = 8, MX_N = MX_GL + MX_GC + MX_AL + MX_FL + MX_AC + MX_FC;
template <int MIXSEL>
DI void phase_mix(const Params& p, int l, unsigned char* lds) {
    xcd_queue(p, l, 1, MX_N, lds, [&](int x, int it) {
        if (it < MX_GL) { if (MIXSEL & 1) gla_chain(p, l, false, x, it >> 1, it & 1, lds); return; } it -= MX_GL;
        if (it < MX_FL) { if (MIXSEL & 4) dft_lat_tile(p, x, it >> 2, it & 3, lds); return; } it -= MX_FL;
        if (it < MX_GC) { const int g = x * 16 + it; if (MIXSEL & 1) gla_chain(p, l, true, g >> 3, (g >> 1) & 3, g & 1, lds); return; } it -= MX_GC;
        if (it < MX_AL) { if (MIXSEL & 2) attn_tile(p, l, false, x, it >> 5, it & 31, lds); return; } it -= MX_AL;
        if (it < MX_AC) { const int g = x * 16 + it; if (MIXSEL & 2) attn_tile(p, l, true, g >> 3, (g >> 1) & 3, g & 1, lds); return; } it -= MX_AC;
        { const int g = x * 8 + it; if (MIXSEL & 4) dft_tile(p, true, g >> 2, 0, g & 3, lds); }
    });
}

DI void mrg_tile(const Params& p, int l, int mtile, int ntile, unsigned char* lds) {
    const int tid = get_tid(), lane = tid & 63, w = tid >> 6, wm = w >> 1, wn = w & 1, lh = lane >> 5, l31 = lane & 31;
    unsigned char* ws = p.ws;
    const int m0 = mtile * 256, n0 = ntile * 128;
    unsigned totpk[2][2][8];
    ALoadBF alh{(const bf16_t*)(ws + O_ZT) + (size_t)m0 * 1024, 1024};
#pragma unroll 1
    for (int br = 0; br < 3; ++br) {
        unsigned gpk[2][2][8];
        {
            f32x16 g[2][2]; acc_zero<2>(g);
            gemm_kloop<2>(g, alh, (const bf16_t*)(ws + O_WGT) + (size_t)(br * 1024 + n0) * 1024, 1024, 1024, lds);
#pragma unroll
            for (int a = 0; a < 2; ++a)
#pragma unroll
                for (int b = 0; b < 2; ++b)
#pragma unroll
                    for (int r = 0; r < 8; ++r) gpk[a][b][r] = pk2(sigmoidf_(g[a][b][2 * r]), sigmoidf_(g[a][b][2 * r + 1]));
        }
        f32x16 y[2][2]; acc_zero<2>(y);
        const bf16_t* Ab = br == 0 ? (const bf16_t*)(ws + O_HB) : (br == 1 ? (const bf16_t*)(ws + O_HB) + (size_t)NTOK * 512 : (const bf16_t*)(ws + O_QD));
        const bf16_t* Wb = (const bf16_t*)(ws + (br == 0 ? O_WFOU : (br == 1 ? O_WGO : O_WDO)));
        ALoadBF al{Ab + (size_t)m0 * 512, 512};
        gemm_kloop<2>(y, al, Wb + (size_t)n0 * 512, 512, 512, lds);
#pragma unroll
        for (int a = 0; a < 2; ++a)
#pragma unroll
            for (int b = 0; b < 2; ++b)
#pragma unroll
                for (int r = 0; r < 8; ++r) {
                    float t0 = bf2f(gpk[a][b][r] & 0xffffu) * y[a][b][2 * r], t1 = bf2f(gpk[a][b][r] >> 16) * y[a][b][2 * r + 1];
                    if (br > 0) { t0 += bf2f(totpk[a][b][r] & 0xffffu); t1 += bf2f(totpk[a][b][r] >> 16); }
                    totpk[a][b][r] = pk2(t0, t1);
                }
    }
    bf16_t* mg = (bf16_t*)(ws + O_MG);
#pragma unroll
    for (int mt = 0; mt < 2; ++mt) { const int row = m0 + wm * 64 + mt * 32 + l31;
#pragma unroll
        for (int nt = 0; nt < 2; ++nt)
#pragma unroll
            for (int gp = 0; gp < 2; ++gp) { u32x2 oa, ob; oa.x = totpk[mt][nt][4 * gp]; oa.y = totpk[mt][nt][4 * gp + 1]; ob.x = totpk[mt][nt][4 * gp + 2]; ob.y = totpk[mt][nt][4 * gp + 3];
                st_pair16(mg + (size_t)row * 1024 + n0 + wn * 64 + nt * 32 + gp * 16, oa, ob, lh); } }
}

DI void res_tile(const Params& p, int l, int mtile, int ntile, const bf16_t* A, int lda, const bf16_t* Bt, int K, int gofs, bool first, unsigned char* lds) {
    const int tid = get_tid(), lane = tid & 63, w = tid >> 6, wm = w >> 1, wn = w & 1, lh = lane >> 5, l31 = lane & 31;
    const int m0 = mtile * 256, n0 = ntile * 128;
    f32x16 acc[2][2]; acc_zero<2>(acc);
    ALoadBF al{A + (size_t)m0 * lda, lda};
    gemm_kloop<2>(acc, al, Bt + (size_t)n0 * K, K, K, lds);
    const float* gv = (const float*)(p.ws + O_MOD) + ((size_t)l * 9 + tok_r(m0)) * 6144 + gofs;
#pragma unroll
    for (int mt = 0; mt < 2; ++mt) { const int row = m0 + wm * 64 + mt * 32 + l31;
        const float* xi = first ? xrow_ptr(p, l, row) : p.out + (size_t)row * 1024;
        float* xo = p.out + (size_t)row * 1024;
#pragma unroll
        for (int nt = 0; nt < 2; ++nt)
#pragma unroll
            for (int g = 0; g < 4; ++g) { const int c = n0 + wn * 64 + nt * 32 + g * 8 + lh * 4;
                const float4 xv = *(const float4*)(xi + c), gg = *(const float4*)(gv + c);
                *(float4*)(xo + c) = make_float4(xv.x + gg.x * acc[mt][nt][4 * g], xv.y + gg.y * acc[mt][nt][4 * g + 1], xv.z + gg.z * acc[mt][nt][4 * g + 2], xv.w + gg.w * acc[mt][nt][4 * g + 3]); } }
}

DI void ff1_tile(const Params& p, int mtile, int ntile, unsigned char* lds) {
    const int tid = get_tid(), lane = tid & 63, w = tid >> 6, wm = w >> 1, wn = w & 1, lh = lane >> 5, l31 = lane & 31;
    unsigned char* ws = p.ws;
    const int m0 = mtile * 256;
    f32x16 acc[2][4]; acc_zero<4>(acc);
    ALoadBF al{(const bf16_t*)(ws + O_HB) + (size_t)m0 * 1024, 1024};
    gemm_kloop<4>(acc, al, (const bf16_t*)(ws + O_WGU) + (size_t)ntile * 256 * 1024, 1024, 1024, lds);
    bf16_t* act = (bf16_t*)(ws + O_ACT);
#pragma unroll
    for (int mt = 0; mt < 2; ++mt) { const int row = m0 + wm * 64 + mt * 32 + l31;
#pragma unroll
        for (int pr = 0; pr < 2; ++pr)
#pragma unroll
        for (int gp = 0; gp < 2; ++gp) { u32x2 ob[2];
#pragma unroll
            for (int h2 = 0; h2 < 2; ++h2) { const int g = 2 * gp + h2; float v[4];
#pragma unroll
                for (int e = 0; e < 4; ++e) v[e] = siluf_(acc[mt][2 * pr][4 * g + e]) * acc[mt][2 * pr + 1][4 * g + e];
                ob[h2].x = pk2(v[0], v[1]); ob[h2].y = pk2(v[2], v[3]); }
            st_pair16(act + (size_t)row * DFF + (2 * ntile + wn) * 64 + pr * 32 + gp * 16, ob[0], ob[1], lh); } }
}

DI void grid_barrier(unsigned* bar, unsigned nblk) {
    __syncthreads();
    if (get_tid() == 0) {
        __builtin_amdgcn_fence(__ATOMIC_RELEASE, "agent");
        unsigned* gen = bar + 320;
        const unsigned g0 = __hip_atomic_load(gen, __ATOMIC_RELAXED, __HIP_MEMORY_SCOPE_AGENT);
        const unsigned grp = (unsigned)get_bid() & 7u;
        const unsigned per = nblk >> 3, extra = nblk & 7u;
        const unsigned want = per + (grp < extra ? 1u : 0u);
        bool released = false;
        if (__hip_atomic_fetch_add(bar + 32 * grp, 1u, __ATOMIC_RELAXED, __HIP_MEMORY_SCOPE_AGENT) == want - 1) {
            const unsigned ngrp = per ? 8u : extra;
            if (__hip_atomic_fetch_add(bar + 288, 1u, __ATOMIC_RELAXED, __HIP_MEMORY_SCOPE_AGENT) == ngrp - 1) {
#pragma unroll
                for (int i = 0; i < 8; ++i) __hip_atomic_store(bar + 32 * i, 0u, __ATOMIC_RELAXED, __HIP_MEMORY_SCOPE_AGENT);
                __hip_atomic_store(bar + 288, 0u, __ATOMIC_RELAXED, __HIP_MEMORY_SCOPE_AGENT);
                __hip_atomic_fetch_add(gen, 1u, __ATOMIC_RELEASE, __HIP_MEMORY_SCOPE_AGENT);
                released = true;
            }
        }
        if (!released) while (__hip_atomic_load(gen, __ATOMIC_RELAXED, __HIP_MEMORY_SCOPE_AGENT) == g0) __builtin_amdgcn_s_sleep(1);
        __builtin_amdgcn_fence(__ATOMIC_ACQUIRE, "agent");
    }
    __syncthreads();
}

#define EN(n) ((MASK >> (n)) & 1)
template <int MASK, int MIXSEL>
__global__ void __launch_bounds__(NTH) fwd_kernel(Params p) {
    extern __shared__ __attribute__((aligned(16))) unsigned char lds[];
    cg::grid_group grid = cg::this_grid();
    const Params& p0 = p;
    for (int ph = p0.ph_lo; ph < p0.ph_hi; ++ph) {
        if (ph == p0.ph_lo + 1) grid.sync();
        else if (ph > p0.ph_lo) grid_barrier((unsigned*)(p0.ws + O_BAR), (unsigned)get_nblk());
        Params p = p0;
        asm volatile("" : "+s"(p.ws)); asm volatile("" : "+s"(p.out));
        if (ph == 0) { if (EN(0)) phase_prep(p, lds); continue; }
        if (ph == 1) { if (EN(1)) phase_modreduce(p); continue; }
        const int l = (ph - 2) / 9, q = (ph - 2) % 9;
        unsigned char* ws = p.ws;
        switch (q) {
        case 0: if (!EN(2)) break;
            if (l > 0) { convert_weights(p, l, lds); convert_cache(p, l); }
            phase_norm(p, l, 0, O_HB);
            break;
        case 1: if (!EN(3)) break;
            xcd_queue(p, l, 0, 18 * 17, lds, [&](int x, int j) { const int g = j / 102, r = j % 102; g1_tile(p, l, mtile_of(x, 6 * g + r % 6), r / 6, lds); });
            break;
        case 2: if (!EN(4)) break;
            phase_mix<MIXSEL>(p, l, lds);
            break;
        case 3: if (!EN(2)) break;
            phase_norm(p, l, 0, O_ZT);
            gla_combine(p, l);
            break;
        case 4: if (!EN(5)) break;
            xcd_queue(p, l, 2, 18 * 8, lds, [&](int x, int j) { mrg_tile(p, l, mtile_of(x, j >> 3), j & 7, lds); });
            break;
        case 5: if (!EN(6)) break;
            xcd_queue(p, l, 3, 18 * 8, lds, [&](int x, int j) { res_tile(p, l, mtile_of(x, j >> 3), j & 7, (const bf16_t*)(ws + O_MG), 1024, (const bf16_t*)(ws + O_WOUT), 1024, 2048, true, lds); });
            break;
        case 6: if (!EN(7)) break;
            phase_norm(p, l, 1, O_HB);
            break;
        case 7: if (!EN(8)) break;
            xcd_queue(p, l, 4, 18 * 22, lds, [&](int x, int j) { const int g = j / 132, r = j % 132; ff1_tile(p, mtile_of(x, 6 * g + r % 6), r / 6, lds); });
            break;
        case 8: if (!EN(9)) break;
            xcd_queue(p, l, 5, 18 * 8, lds, [&](int x, int j) { res_tile(p, l, mtile_of(x, j >> 3), j & 7, (const bf16_t*)(ws + O_ACT), DFF, (const bf16_t*)(ws + O_WDN), DFF, 5120, false, lds); });
            break;
        }
    }
}

template <int MASK, int MIXSEL>
static void launch_ph(const Params& p0, int ph, int grid, hipStream_t stream) {
    static bool attr = false;
    if (!attr) { (void)hipFuncSetAttribute((const void*)fwd_kernel<MASK, MIXSEL>, hipFuncAttributeMaxDynamicSharedMemorySize, LDS_BYTES); attr = true; }
    Params p = p0; p.ph_lo = ph; p.ph_hi = ph + 1;
    hipLaunchKernelGGL((fwd_kernel<MASK, MIXSEL>), dim3(grid), dim3(NTH), LDS_BYTES, stream, p);
}

extern "C" void kernel_launch(void* const* d_in, const int* in_sizes, int n_in, void* d_out, int out_size, void* d_ws, size_t ws_size, hipStream_t stream) {
    static int grid_blocks = 0;
    if (grid_blocks == 0) {
        if (ws_size < WS_END) { fprintf(stderr, "workspace too small: %zu < %zu\n", ws_size, (size_t)WS_END); grid_blocks = -1; return; }
        int dev = 0, cus = 0;
        (void)hipGetDevice(&dev);
        (void)hipDeviceGetAttribute(&cus, hipDeviceAttributeMultiprocessorCount, dev);
        grid_blocks = cus > 0 ? cus : 256;
#if ONE_LAUNCH
        int per_cu = 0;
        if (hipFuncSetAttribute((const void*)fwd_kernel<0xffff, 7>, hipFuncAttributeMaxDynamicSharedMemorySize, LDS_BYTES) != hipSuccess) { fprintf(stderr, "hipFuncSetAttribute failed\n"); grid_blocks = -1; return; }
        (void)hipOccupancyMaxActiveBlocksPerMultiprocessor(&per_cu, (const void*)fwd_kernel<0xffff, 7>, NTH, LDS_BYTES);
        if (per_cu < 1) per_cu = 1;
        grid_blocks = cus * per_cu;
#endif
        (void)hipGetLastError();
    }
    if (grid_blocks < 0) return;
    (void)hipMemsetAsync((unsigned char*)d_ws + O_CNT, 0, 1024 + 2048, stream);
    Params p{};
    for (int i = 0; i < 25; ++i) p.in[i] = (const float*)d_in[i];
    p.out = (float*)d_out; p.ws = (unsigned char*)d_ws;
    constexpr int NPH = 2 + 9 * DEPTH;
#if ONE_LAUNCH
    p.ph_lo = 0; p.ph_hi = NPH;
    void* args[] = {&p};
    hipError_t e = hipLaunchCooperativeKernel((const void*)fwd_kernel<0xffff, 7>, dim3(grid_blocks), dim3(NTH), args, LDS_BYTES, stream);
    if (e != hipSuccess) fprintf(stderr, "cooperative launch failed: %s (grid %d)\n", hipGetErrorString(e), grid_blocks);
#else
    for (int ph = 0; ph < NPH; ++ph) {
        const int q = ph < 2 ? -1 : (ph - 2) % 9;
        if (q == -1 || q == 0 || q == 3 || q == 6) launch_ph<0x0087, 0>(p, ph, grid_blocks, stream);
        else if (q == 1) launch_ph<0x0008, 0>(p, ph, grid_blocks, stream);
        else if (q == 2) { launch_ph<0x0010, 1>(p, ph, grid_blocks, stream); launch_ph<0x0010, 6>(p, ph, grid_blocks, stream); }
        else if (q == 4) launch_ph<0x0020, 0>(p, ph, grid_blocks, stream);
        else launch_ph<0x0340, 0>(p, ph, grid_blocks, stream);
    }
#endif
}
```
